# Optimizing an MI355X kernel written in HIP

```python
import jax, jax.numpy as jnp
from jax import lax
import numpy as np

D_MODEL = 1024
BATCH = 8
SEQ = 4096
DEPTH = 4

HEAD_DIM = 64
ROT_DIM = HEAD_DIM // 4
ROPE_THETA = 500000.0
N_MIXERS = 3
A_HEADS = D_MODEL // HEAD_DIM
A_KV_HEADS = 4
A_WINDOW = 128
WIN_BLK = 128
B_HEADS = D_MODEL // HEAD_DIM
B_GROUPS = ((128, 1), (512, 4), (2048, 16))
C_HEADS = D_MODEL // HEAD_DIM
MOBA_BLOCK = 256
MOBA_TOPK = 3
MOBA_QCHUNK = 16
D_FF = ((8 * D_MODEL + 3 * 256 - 1) // (3 * 256)) * 256
DN_ALPHA = (2 * DEPTH) ** 0.25
DN_BETA = (8 * DEPTH) ** -0.25
LN_EPS = 1e-5
NEG = -1e30

kernel_name = "hybrid_swa_dilated_moba_deepnorm"


def layer_norm(x, g, b):
    xf = x.astype(jnp.float32)
    mu = xf.mean(-1, keepdims=True)
    var = jnp.square(xf - mu).mean(-1, keepdims=True)
    return ((xf - mu) * lax.rsqrt(var + LN_EPS) * g.astype(jnp.float32) + b.astype(jnp.float32)).astype(x.dtype)


def rope_tables(positions):
    inv = ROPE_THETA ** (-jnp.arange(0, ROT_DIM, 2, dtype=jnp.float32) / ROT_DIM)
    ang = positions.astype(jnp.float32)[..., None] * inv
    return jnp.cos(ang), jnp.sin(ang)


def apply_rope(x, cos, sin):
    xf = x.astype(jnp.float32)
    half = ROT_DIM // 2
    x1, x2 = xf[..., :half], xf[..., half:ROT_DIM]
    c, s = cos[:, :, None, :], sin[:, :, None, :]
    return jnp.concatenate([x1 * c - x2 * s, x2 * c + x1 * s, xf[..., ROT_DIM:]], axis=-1).astype(x.dtype)


def block_attention(q, k, v, blk, n_back, with_prev, sink=None):
    B, L, Hq, dh = q.shape
    Hkv = k.shape[2]
    G = Hq // Hkv
    nb = L // blk
    qb = q.astype(jnp.float32).reshape(B, nb, blk, Hkv, G, dh)
    kb = k.astype(jnp.float32).reshape(B, nb, blk, Hkv, dh)
    vb = v.astype(jnp.float32).reshape(B, nb, blk, Hkv, dh)
    if with_prev:
        shift = lambda t: jnp.pad(t, ((0, 0), (1, 0), (0, 0), (0, 0), (0, 0)))[:, :-1]
        kb = jnp.concatenate([shift(kb), kb], axis=2)
        vb = jnp.concatenate([shift(vb), vb], axis=2)
    off = blk if with_prev else 0
    nk = kb.shape[2]
    s = jnp.einsum('bnqhgd,bnkhd->bnhgqk', qb, kb) * (dh ** -0.5)
    diff = jnp.arange(blk)[:, None] + off - jnp.arange(nk)[None, :]
    ok = ((diff >= 0) & (diff <= n_back))[None]
    if with_prev:
        ok = ok & ((jnp.arange(nb)[:, None, None] > 0) | (jnp.arange(nk)[None, None, :] >= blk))
    s = jnp.where(ok[None, :, None, None], s, NEG)
    m = s.max(-1)
    if sink is not None:
        sk = sink.astype(jnp.float32).reshape(1, 1, Hkv, G, 1)
        m = jnp.maximum(m, sk)
    p = jnp.exp(s - m[..., None])
    l = p.sum(-1)
    if sink is not None:
        l = l + jnp.exp(sk - m)
    o = jnp.einsum('bnhgqk,bnkhd->bnqhgd', p, vb) / jnp.transpose(l, (0, 1, 4, 2, 3))[..., None]
    lse = jnp.transpose(m + jnp.log(l), (0, 1, 4, 2, 3)).reshape(B, L, Hq)
    return o.reshape(B, L, Hq, dh), lse


def mixer_a(x, w_qkv, b_qkv, sinks, w_o, b_o, cos, sin):
    B, S, _ = x.shape
    nq, nkv = A_HEADS * HEAD_DIM, A_KV_HEADS * HEAD_DIM
    qkv = x @ w_qkv + b_qkv
    q = apply_rope(qkv[..., :nq].reshape(B, S, A_HEADS, HEAD_DIM), cos, sin)
    k = apply_rope(qkv[..., nq:nq + nkv].reshape(B, S, A_KV_HEADS, HEAD_DIM), cos, sin)
    v = qkv[..., nq + nkv:].reshape(B, S, A_KV_HEADS, HEAD_DIM)
    o, _ = block_attention(q, k, v, WIN_BLK, A_WINDOW - 1, True, sinks)
    return o.reshape(B, S, nq).astype(x.dtype) @ w_o + b_o


def dilated_attention(q, k, v, window, dil):
    B, S, H, dh = q.shape
    span = dil * WIN_BLK
    S_pad = -(-S // span) * span
    L = S_pad // dil

    def to_phase(t):
        t = jnp.pad(t, ((0, 0), (0, S_pad - S), (0, 0), (0, 0)))
        return jnp.transpose(t.reshape(B, L, dil, H, dh), (0, 2, 1, 3, 4)).reshape(B * dil, L, H, dh)

    o, lse = block_attention(to_phase(q), to_phase(k), to_phase(v), WIN_BLK, window // dil, True)
    o = jnp.transpose(o.reshape(B, dil, L, H, dh), (0, 2, 1, 3, 4)).reshape(B, S_pad, H, dh)[:, :S]
    lse = jnp.transpose(lse.reshape(B, dil, L, H), (0, 2, 1, 3)).reshape(B, S_pad, H)[:, :S]
    return o, lse


def mixer_b(x, w_qkv, w_o, cos, sin):
    B, S, _ = x.shape
    qkv = (x @ w_qkv).reshape(B, S, len(B_GROUPS), 3, B_HEADS, HEAD_DIM)
    outs, lses = [], []
    for g, (window, dil) in enumerate(B_GROUPS):
        q = apply_rope(qkv[:, :, g, 0], cos, sin)
        k = apply_rope(qkv[:, :, g, 1], cos, sin)
        o, lse = dilated_attention(q, k, qkv[:, :, g, 2], window, dil)
        outs.append(o)
        lses.append(lse)
    w = jax.nn.softmax(jnp.stack(lses), axis=0)
    o = jnp.sum(w[..., None] * jnp.stack(outs), axis=0)
    return o.reshape(B, S, B_HEADS * HEAD_DIM).astype(x.dtype) @ w_o


def mixer_c(x, w_qkv, w_o, cos, sin):
    B, S, _ = x.shape
    H, dh = C_HEADS, HEAD_DIM
    qkv = (x @ w_qkv).reshape(B, S, 3, H, dh)
    q = apply_rope(qkv[:, :, 0], cos, sin)
    k = apply_rope(qkv[:, :, 1], cos, sin)
    v = qkv[:, :, 2]
    S_pad = -(-S // MOBA_BLOCK) * MOBA_BLOCK
    nblk = S_pad // MOBA_BLOCK
    pad = ((0, 0), (0, S_pad - S), (0, 0), (0, 0))
    q, k, v = jnp.pad(q, pad), jnp.pad(k, pad), jnp.pad(v, pad)
    o_self, lse_self = block_attention(q, k, v, MOBA_BLOCK, MOBA_BLOCK - 1, False)
    qf = q.astype(jnp.float32)
    kblk = k.reshape(B, nblk, MOBA_BLOCK, H, dh)
    vblk = v.reshape(B, nblk, MOBA_BLOCK, H, dh)
    kmean = kblk.astype(jnp.float32).mean(axis=2)
    gate = jnp.einsum('bshd,bnhd->bshn', qf, kmean)
    n_past = jnp.arange(S_pad) // MOBA_BLOCK
    gate = jnp.where((jnp.arange(nblk)[None, :] < n_past[:, None])[None, :, None, :], gate, NEG)
    topk = min(MOBA_TOPK, nblk)
    _, idx = lax.top_k(gate, topk)
    valid = jnp.arange(topk)[None, :] < n_past[:, None]
    kbt = jnp.transpose(kblk, (0, 3, 1, 2, 4))
    vbt = jnp.transpose(vblk, (0, 3, 1, 2, 4))
    nc = S_pad // MOBA_QCHUNK
    q_c = jnp.transpose(qf.reshape(B, nc, MOBA_QCHUNK, H, dh), (1, 0, 2, 3, 4))
    i_c = jnp.transpose(idx.reshape(B, nc, MOBA_QCHUNK, H, topk), (1, 0, 2, 3, 4))
    v_c = valid.reshape(nc, MOBA_QCHUNK, topk)
    bi = jnp.arange(B)[:, None, None, None]
    hi = jnp.arange(H)[None, None, :, None]
    scale = dh ** -0.5

    def chunk(args):
        qc, ic, vc = args
        kg = kbt[bi, hi, ic].astype(jnp.float32)
        vg = vbt[bi, hi, ic].astype(jnp.float32)
        s = jnp.einsum('bqhd,bqhjkd->bqhjk', qc, kg) * scale
        s = jnp.where(vc[None, :, None, :, None], s, NEG)
        m = s.max(axis=(-2, -1))
        p = jnp.exp(s - m[..., None, None])
        l = p.sum(axis=(-2, -1))
        o = jnp.einsum('bqhjk,bqhjkd->bqhd', p, vg) / l[..., None]
        return o, m + jnp.log(l)

    o_sel, lse_sel = lax.map(chunk, (q_c, i_c, v_c))
    o_sel = jnp.transpose(o_sel, (1, 0, 2, 3, 4)).reshape(B, S_pad, H, dh)
    lse_sel = jnp.transpose(lse_sel, (1, 0, 2, 3)).reshape(B, S_pad, H)
    m = jnp.maximum(lse_self, lse_sel)
    w1 = jnp.exp(lse_self - m)
    w2 = jnp.exp(lse_sel - m)
    o = (w1[..., None] * o_self + w2[..., None] * o_sel) / (w1 + w2)[..., None]
    return o[:, :S].reshape(B, S, H * dh).astype(x.dtype) @ w_o


def swiglu(x, w_gate_up, w_down):
    gu = x @ w_gate_up
    gate, up = gu[..., :D_FF], gu[..., D_FF:]
    return (jax.nn.silu(gate) * up) @ w_down


def setup_inputs(seed: int = 0) -> dict:
    key = jax.random.key(seed)
    ks = jax.random.split(key, 16)
    n_a = (DEPTH + 2) // 3
    n_b = (DEPTH + 1) // 3
    n_c = DEPTH // 3
    D = D_MODEL
    a_cols = (A_HEADS + 2 * A_KV_HEADS) * HEAD_DIM
    b_cols = len(B_GROUPS) * 3 * B_HEADS * HEAD_DIM
    c_cols = 3 * C_HEADS * HEAD_DIM
    nrm = lambda k, shape, fan_in, s=1.0: jax.random.normal(k, shape, jnp.float32) * (fan_in ** -0.5) * s
    return {
        "x": jax.random.normal(ks[0], (BATCH, SEQ, D), jnp.float32),
        "positions": jnp.broadcast_to(jnp.arange(SEQ, dtype=jnp.int32), (BATCH, SEQ)),
        "ln_g": 1.0 + 0.02 * jax.random.normal(ks[1], (DEPTH, 2, D), jnp.float32),
        "ln_b": 0.02 * jax.random.normal(ks[2], (DEPTH, 2, D), jnp.float32),
        "a_w_qkv": nrm(ks[3], (n_a, D, a_cols), D),
        "a_b_qkv": 0.02 * jax.random.normal(ks[4], (n_a, a_cols), jnp.float32),
        "a_sinks": 0.5 * jax.random.normal(ks[5], (n_a, A_HEADS), jnp.float32),
        "a_w_o": nrm(ks[6], (n_a, A_HEADS * HEAD_DIM, D), A_HEADS * HEAD_DIM, DN_BETA),
        "a_b_o": 0.02 * jax.random.normal(ks[7], (n_a, D), jnp.float32),
        "b_w_qkv": nrm(ks[8], (n_b, D, b_cols), D),
        "b_w_o": nrm(ks[9], (n_b, B_HEADS * HEAD_DIM, D), B_HEADS * HEAD_DIM, DN_BETA),
        "c_w_qkv": nrm(ks[10], (n_c, D, c_cols), D),
        "c_w_o": nrm(ks[11], (n_c, C_HEADS * HEAD_DIM, D), C_HEADS * HEAD_DIM, DN_BETA),
        "w_gate_up": nrm(ks[12], (DEPTH, D, 2 * D_FF), D),
        "w_down": nrm(ks[13], (DEPTH, D_FF, D), D_FF, DN_BETA),
    }


def reference(x, positions, ln_g, ln_b, a_w_qkv, a_b_qkv, a_sinks, a_w_o, a_b_o,
              b_w_qkv, b_w_o, c_w_qkv, c_w_o, w_gate_up, w_down):
    cos, sin = rope_tables(positions)
    for i in range(DEPTH):
        kind, j = i % N_MIXERS, i // N_MIXERS
        if kind == 0:
            h = mixer_a(x, a_w_qkv[j], a_b_qkv[j], a_sinks[j], a_w_o[j], a_b_o[j], cos, sin)
        elif kind == 1:
            h = mixer_b(x, b_w_qkv[j], b_w_o[j], cos, sin)
        else:
            h = mixer_c(x, c_w_qkv[j], c_w_o[j], cos, sin)
        x = layer_norm(DN_ALPHA * x + h, ln_g[i, 0], ln_b[i, 0])
        x = layer_norm(DN_ALPHA * x + swiglu(x, w_gate_up[i], w_down[i]), ln_g[i, 1], ln_b[i, 1])
    return x
```

```cpp
#include <hip/hip_runtime.h>
#include <hip/hip_cooperative_groups.h>
#include <cstdio>
#include <cstdint>
namespace cg = cooperative_groups;

#define LAS __attribute__((address_space(3)))
typedef unsigned short bf16_t;
typedef short bf16x8 __attribute__((ext_vector_type(8)));
typedef float f32x4 __attribute__((ext_vector_type(4)));
typedef float f32x2 __attribute__((ext_vector_type(2)));
typedef float f32x16 __attribute__((ext_vector_type(16)));
typedef unsigned u32x4 __attribute__((ext_vector_type(4)));
typedef unsigned u32x2 __attribute__((ext_vector_type(2)));
typedef short s16x4 __attribute__((ext_vector_type(4)));
typedef __bf16 bf16x2_t __attribute__((ext_vector_type(2)));

#ifndef MK_MULTI
#define MK_MULTI 0
#endif

constexpr int BATCH = 8, SEQ = 4096, DM = 1024, MTOK = BATCH * SEQ, DFF = 2816, HD = 64, DEPTH = 4;
constexpr float DN_ALPHA = 1.6817928305074290861f;
constexpr float LN_EPS = 1e-5f;
constexpr float LOG2E = 1.4426950408889634f;
constexpr float QSCALE = 0.125f * LOG2E;

__device__ __forceinline__ unsigned cvtpk(float lo, float hi) { f32x2 v = {lo, hi}; bf16x2_t b = __builtin_convertvector(v, bf16x2_t); return __builtin_bit_cast(unsigned, b); }
__device__ __forceinline__ float shflx(float v, int mask, int lane) { return __int_as_float(__builtin_amdgcn_ds_bpermute((lane ^ mask) << 2, __float_as_int(v))); }
__device__ __forceinline__ float bf2f(unsigned short b) { return __uint_as_float(((unsigned)b) << 16); }

namespace pg8 {
constexpr int BM = 256, BK = 64, HALF = 128, HTB = HALF * BK * 2, STAGE_BYTES = 8 * HTB, NXCD = 8, WGM = 8;
__host__ __device__ __forceinline__ int lds_byte(int r, int c) { const int st = (r >> 4) * 2 + (c >> 5), rr = r & 15, cc = c & 31, ob = rr * 64 + cc * 2; return st * 1024 + (ob ^ (((ob >> 9) & 1) << 5)); }
__host__ __device__ __forceinline__ void stage_rc(int b, int& R, int& C) { const int st = b / 1024, sb = b % 1024, swz = sb ^ (((sb >> 9) & 1) << 5); R = (st >> 1) * 16 + swz / 64; C = (st & 1) * 32 + (swz % 64) / 2; }
__host__ __device__ __forceinline__ int perm32(int rho) { const int n = rho >> 4, i = rho & 15; return 8 * (i >> 2) + 4 * n + (i & 3); }
struct Unit { int pm, pn; };
struct Gemm { const bf16_t* A; const bf16_t* Bt; int M, N, K; };
struct StaticOrder {
    int nM, nN, nwg, G, c;
    __host__ __device__ void init(int M, int N, int G_, int c_) { nM = M / BM; nN = N / BM; nwg = nM * nN; G = G_; c = c_; }
    __host__ __device__ bool next(int i, Unit& u) const {
        const long L = (long)i * G + c; if (L >= nwg) return false;
        int wgid = (int)L; { const int q = nwg / NXCD, r = nwg % NXCD, xcd = wgid % NXCD, off = wgid / NXCD; wgid = (xcd < r ? xcd * (q + 1) : r * (q + 1) + (xcd - r) * q) + off; }
        const int nig = WGM * nN, gid = wgid / nig, fm = gid * WGM, gsz = (nM - fm) < WGM ? (nM - fm) : WGM;
        u.pm = fm + ((wgid % nig) % gsz); u.pn = (wgid % nig) / gsz; return true;
    }
};

struct EpiQKV {
    static constexpr bool PERM = true, AFTER_DRAIN = false, FUSED_MID = false;
    bf16_t* O; int ldc; const float* bias; int rope_cols, q_cols; const float* rope;
    __device__ __forceinline__ void operator()(const f32x4 (&acc)[2][2][4][2], const Unit& u, int wr, int wc, int fr, int fq) const {
        const int row0 = u.pm * BM + wr * 64 + fr, colt = u.pn * BM, col0 = colt + wc * 32 + 8 * fq;
        const bool do_rope = (colt < rope_cols) && ((wc & 1) == 0);
        const float sc = (colt < q_cols) ? QSCALE : 1.0f;
        f32x4 bv[2][2];
#pragma unroll
        for (int bj = 0; bj < 2; ++bj)
#pragma unroll
            for (int n = 0; n < 2; ++n) bv[bj][n] = bias ? *(const f32x4*)(bias + col0 + bj * HALF + 4 * n) : (f32x4){0.f, 0.f, 0.f, 0.f};
        f32x4 csa[2][4], sna[2][4];
        if (do_rope) {
#pragma unroll
            for (int e = 0; e < 6; ++e) { const int ai = e >> 2, m = e & 3; const float* rp = rope + (size_t)(row0 + ai * HALF + m * 16) * 16 + 4 * (fq & 1); csa[ai][m] = *(const f32x4*)rp; sna[ai][m] = *(const f32x4*)(rp + 8); }
        }
#pragma unroll
        for (int ai = 0; ai < 2; ++ai) {
            if (ai == 1) {
                asm volatile("" ::: "memory");
                if (do_rope) {
#pragma unroll
                    for (int m = 2; m < 4; ++m) { const float* rp = rope + (size_t)(row0 + HALF + m * 16) * 16 + 4 * (fq & 1); csa[1][m] = *(const f32x4*)rp; sna[1][m] = *(const f32x4*)(rp + 8); }
                }
            }
#pragma unroll
            for (int m = 0; m < 4; ++m) {
                bf16_t* rowp = O + (size_t)(row0 + ai * HALF + m * 16) * ldc + col0;
#pragma unroll
                for (int bj = 0; bj < 2; ++bj) {
                    f32x4 v0 = acc[ai][bj][m][0] + bv[bj][0], v1 = acc[ai][bj][m][1] + bv[bj][1];
                    if (do_rope && fq < 2) {
                        const f32x4 c = csa[ai][m], s_ = sna[ai][m];
                        const f32x4 r0 = {v0[0] * c[0] - v0[1] * s_[0], v0[1] * c[0] + v0[0] * s_[0], v0[2] * c[1] - v0[3] * s_[1], v0[3] * c[1] + v0[2] * s_[1]};
                        const f32x4 r1 = {v1[0] * c[2] - v1[1] * s_[2], v1[1] * c[2] + v1[0] * s_[2], v1[2] * c[3] - v1[3] * s_[3], v1[3] * c[3] + v1[2] * s_[3]};
                        v0 = r0; v1 = r1;
                    }
                    v0 = v0 * sc; v1 = v1 * sc;
                    u32x4 w; w.x = cvtpk(v0[0], v0[1]); w.y = cvtpk(v0[2], v0[3]); w.z = cvtpk(v1[0], v1[1]); w.w = cvtpk(v1[2], v1[3]);
                    *(u32x4*)(rowp + bj * HALF) = w;
                }
            }
        }
    }
};
struct EpiResid {
    static constexpr bool PERM = false, AFTER_DRAIN = false, FUSED_MID = false;
    const float* xres; float* out; const float* bias;
    __device__ __forceinline__ void operator()(const f32x4 (&acc)[2][2][4][2], const Unit& u, int wr, int wc, int fr, int fq) const {
        const int col0 = u.pn * BM + wc * 32 + 4 * fq;
        f32x4 bv[2][2];
#pragma unroll
        for (int bj = 0; bj < 2; ++bj)
#pragma unroll
            for (int n = 0; n < 2; ++n) bv[bj][n] = bias ? *(const f32x4*)(bias + col0 + bj * HALF + n * 16) : (f32x4){0.f, 0.f, 0.f, 0.f};
#pragma unroll
        for (int ai = 0; ai < 2; ++ai)
#pragma unroll
            for (int m = 0; m < 4; ++m) {
                const size_t off = (size_t)(u.pm * BM + ai * HALF + wr * 64 + m * 16 + fr) * DM + col0;
#pragma unroll
                for (int bj = 0; bj < 2; ++bj)
#pragma unroll
                    for (int n = 0; n < 2; ++n) { const f32x4 bs = *(const f32x4*)(xres + off + bj * HALF + n * 16); *(f32x4*)(out + off + bj * HALF + n * 16) = bs * DN_ALPHA + (acc[ai][bj][m][n] + bv[bj][n]); }
            }
    }
};
struct EpiSwiGLU {
    static constexpr bool PERM = true, AFTER_DRAIN = false, FUSED_MID = false;
    bf16_t* H;
    __device__ __forceinline__ void operator()(const f32x4 (&acc)[2][2][4][2], const Unit& u, int wr, int wc, int fr, int fq) const {
        const int col0 = u.pn * HALF + wc * 32 + 8 * fq;
#pragma unroll
        for (int ai = 0; ai < 2; ++ai)
#pragma unroll
            for (int m = 0; m < 4; ++m) {
                bf16_t* rowp = H + (size_t)(u.pm * BM + ai * HALF + wr * 64 + m * 16 + fr) * DFF + col0;
                float h[8];
#pragma unroll
                for (int n = 0; n < 2; ++n)
#pragma unroll
                    for (int i = 0; i < 4; ++i) { const float g = acc[ai][0][m][n][i], up = acc[ai][1][m][n][i]; h[n * 4 + i] = g * __builtin_amdgcn_rcpf(1.0f + __builtin_amdgcn_exp2f(-g * LOG2E)) * up; }
                u32x4 w; w.x = cvtpk(h[0], h[1]); w.y = cvtpk(h[2], h[3]); w.z = cvtpk(h[4], h[5]); w.w = cvtpk(h[6], h[7]);
                *(u32x4*)rowp = w;
            }
    }
};

struct PanelStats {
    unsigned long long* xbuf;
    unsigned* cnt;
    __device__ __forceinline__ void run(const f32x4 (&v)[2][2][4][2], const Unit& u, int wr, int wc, int fr, int fq, LAS unsigned char* lds, int wid, int lane) const {
        LAS f32x2* P = (LAS f32x2*)(lds + STAGE_BYTES);
        LAS f32x2* S = (LAS f32x2*)(lds + STAGE_BYTES + 8192);
#pragma unroll
        for (int ai = 0; ai < 2; ++ai)
#pragma unroll
            for (int m = 0; m < 4; ++m) {
                float s = 0.f;
#pragma unroll
                for (int bj = 0; bj < 2; ++bj)
#pragma unroll
                    for (int n = 0; n < 2; ++n) { const f32x4 x = v[ai][bj][m][n]; s += (x[0] + x[1]) + (x[2] + x[3]); }
                s += shflx(s, 16, lane); s += shflx(s, 32, lane);
                const float mw = s * (1.0f / 64.0f); float q = 0.f;
#pragma unroll
                for (int bj = 0; bj < 2; ++bj)
#pragma unroll
                    for (int n = 0; n < 2; ++n) { const f32x4 d = v[ai][bj][m][n] - mw; q += (d[0] * d[0] + d[1] * d[1]) + (d[2] * d[2] + d[3] * d[3]); }
                q += shflx(q, 16, lane); q += shflx(q, 32, lane);
                if (fq == 0) P[(ai * HALF + wr * 64 + m * 16 + fr) * 4 + wc] = (f32x2){mw, q};
            }
        asm volatile("s_waitcnt lgkmcnt(0)" ::: "memory"); __builtin_amdgcn_s_barrier(); asm volatile("" ::: "memory");
        const int row = wid * 32 + (lane & 31);
        if (lane < 32) {
            const f32x2 a = P[row * 4 + 0], b = P[row * 4 + 1], c = P[row * 4 + 2], d = P[row * 4 + 3];
            const float mt = (a.x + b.x + c.x + d.x) * 0.25f;
            const float da = a.x - mt, db = b.x - mt, dc = c.x - mt, dd = d.x - mt;
            const float m2 = (a.y + b.y) + (c.y + d.y) + 64.0f * ((da * da + db * db) + (dc * dc + dd * dd));
            unsigned long long* slot = xbuf + ((size_t)(u.pm * BM + row) * 4 + u.pn);
            __hip_atomic_store(slot, ((unsigned long long)__float_as_uint(m2) << 32) | __float_as_uint(mt), __ATOMIC_RELAXED, __HIP_MEMORY_SCOPE_AGENT);
        }
        asm volatile("s_waitcnt vmcnt(0)" ::: "memory");
        if (lane == 0) __hip_atomic_fetch_add(cnt + 64 * u.pm, 1u, __ATOMIC_RELAXED, __HIP_MEMORY_SCOPE_AGENT);
        if (wid == 0) {
            unsigned sp = 0u;
            for (;;) {
                if ((unsigned)__builtin_amdgcn_readfirstlane(__hip_atomic_load(cnt + 64 * u.pm, __ATOMIC_RELAXED, __HIP_MEMORY_SCOPE_AGENT)) >= 32u) break;
                if (++sp > (1u << 24)) break;
                __builtin_amdgcn_s_sleep(2);
            }
            __builtin_amdgcn_fence(__ATOMIC_ACQUIRE, "agent");
        }
        asm volatile("s_waitcnt vmcnt(0) lgkmcnt(0)" ::: "memory"); __builtin_amdgcn_s_barrier(); asm volatile("" ::: "memory");
        if (lane < 32) {
            const unsigned long long* slot = xbuf + (size_t)(u.pm * BM + row) * 4; float mt[4], m2[4]; float ms = 0.f;
#pragma unroll
            for (int t = 0; t < 4; ++t) { const unsigned long long w = __hip_atomic_load(slot + t, __ATOMIC_RELAXED, __HIP_MEMORY_SCOPE_AGENT); mt[t] = __uint_as_float((unsigned)w); m2[t] = __uint_as_float((unsigned)(w >> 32)); ms += mt[t]; }
            const float mean = ms * 0.25f; float q = 0.f;
#pragma unroll
            for (int t = 0; t < 4; ++t) { const float dm = mt[t] - mean; q += m2[t] + 256.0f * dm * dm; }
            S[row] = (f32x2){mean, 1.0f / sqrtf(q * (1.0f / 1024.0f) + LN_EPS)};
        }
        asm volatile("s_waitcnt lgkmcnt(0)" ::: "memory"); __builtin_amdgcn_s_barrier(); asm volatile("" ::: "memory");
    }
};
struct EpiLN {
    static constexpr bool PERM = true, AFTER_DRAIN = false, FUSED_MID = true;
    const float* xres; float* out; bf16_t* xn; bf16_t* xlo; const float* bias; const float* gamma; const float* beta; PanelStats st; int rd_lo, wr_lo;
    __device__ __forceinline__ void fused(f32x4 (&acc)[2][2][4][2], const Unit& u, int wr, int wc, int fr, int fq, LAS unsigned char* lds, int wid, int lane) const {
        const LAS f32x2* S = (const LAS f32x2*)(lds + STAGE_BYTES + 8192);
        const int col0 = u.pn * BM + wc * 32 + 8 * fq;
#pragma unroll
        for (int bj = 0; bj < 2; ++bj)
#pragma unroll
            for (int n = 0; n < 2; ++n) { const f32x4 bv = bias ? *(const f32x4*)(bias + col0 + bj * HALF + 4 * n) : (f32x4){0.f, 0.f, 0.f, 0.f};
#pragma unroll
                for (int ai = 0; ai < 2; ++ai)
#pragma unroll
                    for (int m = 0; m < 4; ++m) acc[ai][bj][m][n] += bv; }
#pragma unroll
        for (int ab = 0; ab < 4; ++ab) {
            const int ai = ab >> 1, m0 = (ab & 1) * 2;
            f32x4 xr[2][2][2];
            if (xres) {
#pragma unroll
                for (int mm = 0; mm < 2; ++mm) { const size_t off = (size_t)(u.pm * BM + ai * HALF + wr * 64 + (m0 + mm) * 16 + fr) * DM + col0;
#pragma unroll
                    for (int bj = 0; bj < 2; ++bj)
#pragma unroll
                        for (int n = 0; n < 2; ++n) xr[mm][bj][n] = *(const f32x4*)(xres + off + bj * HALF + 4 * n); }
            } else {
                u32x4 xh[2][2], xl8[2];
#pragma unroll
                for (int mm = 0; mm < 2; ++mm) { const size_t off = (size_t)(u.pm * BM + ai * HALF + wr * 64 + (m0 + mm) * 16 + fr) * DM + col0;
#pragma unroll
                    for (int bj = 0; bj < 2; ++bj) xh[mm][bj] = *(const u32x4*)(xn + off + bj * HALF);
                    xl8[mm] = rd_lo ? *(const u32x4*)(xlo + (((size_t)(u.pm * 4 + u.pn) * 8 + ai * 4 + (m0 + mm)) * 512 + (wid * 64 + lane)) * 8) : (u32x4){0u, 0u, 0u, 0u}; }
#pragma unroll
                for (int mm = 0; mm < 2; ++mm)
#pragma unroll
                    for (int bj = 0; bj < 2; ++bj)
#pragma unroll
                        for (int n = 0; n < 2; ++n)
#pragma unroll
                            for (int i = 0; i < 2; ++i) { const unsigned h = xh[mm][bj][2 * n + i];
                                const f32x2 lr = i ? __builtin_amdgcn_cvt_pk_f32_bf8((int)xl8[mm][bj * 2 + n], true) : __builtin_amdgcn_cvt_pk_f32_bf8((int)xl8[mm][bj * 2 + n], false);
                                xr[mm][bj][n][2 * i] = __uint_as_float(h << 16) + lr[0] * (1.0f / 4096.0f); xr[mm][bj][n][2 * i + 1] = __uint_as_float(h & 0xffff0000u) + lr[1] * (1.0f / 4096.0f); }
            }
#pragma unroll
            for (int mm = 0; mm < 2; ++mm) { const int m = m0 + mm;
#pragma unroll
                for (int bj = 0; bj < 2; ++bj)
#pragma unroll
                    for (int n = 0; n < 2; ++n) acc[ai][bj][m][n] += xr[mm][bj][n] * DN_ALPHA;
                asm volatile("" : "+v"(acc[ai][0][m][0]), "+v"(acc[ai][0][m][1]), "+v"(acc[ai][1][m][0]), "+v"(acc[ai][1][m][1])); }
            asm volatile("" ::: "memory");
        }
        st.run(acc, u, wr, wc, fr, fq, lds, wid, lane);
        f32x4 gv[2][2], bt[2][2];
#pragma unroll
        for (int bj = 0; bj < 2; ++bj)
#pragma unroll
            for (int n = 0; n < 2; ++n) { gv[bj][n] = *(const f32x4*)(gamma + col0 + bj * HALF + 4 * n); bt[bj][n] = *(const f32x4*)(beta + col0 + bj * HALF + 4 * n); }
#pragma unroll
        for (int ai = 0; ai < 2; ++ai)
#pragma unroll
            for (int m = 0; m < 4; ++m) { const int r = ai * HALF + wr * 64 + m * 16 + fr; const f32x2 sr = S[r]; const size_t off = (size_t)(u.pm * BM + r) * DM + col0; u32x4 wl8;
#pragma unroll
                for (int bj = 0; bj < 2; ++bj) {
                    const f32x4 y0 = (acc[ai][bj][m][0] - sr.x) * sr.y * gv[bj][0] + bt[bj][0], y1 = (acc[ai][bj][m][1] - sr.x) * sr.y * gv[bj][1] + bt[bj][1];
                    if (out) { *(f32x4*)(out + off + bj * HALF) = y0; *(f32x4*)(out + off + bj * HALF + 4) = y1; }
                    u32x4 w; w.x = cvtpk(y0[0], y0[1]); w.y = cvtpk(y0[2], y0[3]); w.z = cvtpk(y1[0], y1[1]); w.w = cvtpk(y1[2], y1[3]);
                    *(u32x4*)(xn + off + bj * HALF) = w;
                    { int d0 = __builtin_amdgcn_cvt_pk_bf8_f32((y0[0] - __uint_as_float(w.x << 16)) * 4096.0f, (y0[1] - __uint_as_float(w.x & 0xffff0000u)) * 4096.0f, 0, false);
                      d0 = __builtin_amdgcn_cvt_pk_bf8_f32((y0[2] - __uint_as_float(w.y << 16)) * 4096.0f, (y0[3] - __uint_as_float(w.y & 0xffff0000u)) * 4096.0f, d0, true);
                      int d1 = __builtin_amdgcn_cvt_pk_bf8_f32((y1[0] - __uint_as_float(w.z << 16)) * 4096.0f, (y1[1] - __uint_as_float(w.z & 0xffff0000u)) * 4096.0f, 0, false);
                      d1 = __builtin_amdgcn_cvt_pk_bf8_f32((y1[2] - __uint_as_float(w.w << 16)) * 4096.0f, (y1[3] - __uint_as_float(w.w & 0xffff0000u)) * 4096.0f, d1, true);
                      wl8[bj * 2] = (unsigned)d0; wl8[bj * 2 + 1] = (unsigned)d1; }
                    }
                if (wr_lo) *(u32x4*)(xlo + (((size_t)(u.pm * 4 + u.pn) * 8 + ai * 4 + m) * 512 + (wid * 64 + lane)) * 8) = wl8; }
        asm volatile("s_waitcnt lgkmcnt(0)" ::: "memory"); __builtin_amdgcn_s_barrier(); asm volatile("" ::: "memory");
    }
};
struct OneRound {
    StaticOrder S; int round;
    __device__ bool next(int i, Unit& u) const { return (i == 0) && S.next(round, u); }
};

template <class Epi, class Sched, bool ALIGN_EPI = false, bool SP2 = false>
__device__ __forceinline__ void gemm_phase(LAS unsigned char* lds, const Gemm g, const Sched& S, const Epi& E) {
    int tid_ = threadIdx.x; asm volatile("" : "+v"(tid_));
    const int tid = tid_, wid = __builtin_amdgcn_readfirstlane(tid >> 6), lane = tid & 63, wr = wid >> 2, wc = wid & 3, fr = lane & 15, fq = lane >> 4;
    const bf16_t* gA_ = g.A; const bf16_t* gB_ = g.Bt; asm volatile("" : "+s"(gA_), "+s"(gB_));
    const int K = g.K, nt = K / BK;
    unsigned voffA[2], voffB[2];
#pragma unroll
    for (int i = 0; i < 2; ++i) { int R, C; stage_rc(tid * 16 + i * 8192, R, C); const int Rb = Epi::PERM ? ((R & ~31) + perm32(R & 31)) : R;
        voffA[i] = (unsigned)(R * K + C) * 2u; voffB[i] = (unsigned)(Rb * K + C) * 2u; }
    const size_t kstep = (size_t)(BK * 2);
    const size_t hstep = (size_t)HALF * K * 2;
    const size_t tstep = 2 * hstep;
    const unsigned ldsw = (unsigned)wid * 1024u;
    const int aoff = lds_byte(wr * 64 + fr, fq * 8), boff = lds_byte(wc * 32 + fr, fq * 8);
#define PG8_SA(b, h) (((b) * 2 + (h)) * HTB)
#define PG8_SB(b, h) ((4 + (b) * 2 + (h)) * HTB)
#define PG8_STAGE(bufoff, gbase, voff) do { _Pragma("unroll") for (int _i = 0; _i < 2; ++_i) \
        __builtin_amdgcn_global_load_lds((const unsigned*)((const char*)(gbase) + (voff)[_i]), (LAS unsigned*)(lds + (bufoff) + ldsw + _i * 8192), 16, 0, 0); } while (0)
#define PG8_LDA(dst, b, h) do { _Pragma("unroll") for (int m = 0; m < 4; ++m) _Pragma("unroll") for (int k = 0; k < 2; ++k) dst[m][k] = *(const LAS bf16x8*)(lds + PG8_SA(b, h) + aoff + m * 2048 + k * 1024); } while (0)
#define PG8_LDB(dst, b, h) do { _Pragma("unroll") for (int n = 0; n < 2; ++n) _Pragma("unroll") for (int k = 0; k < 2; ++k) dst[n][k] = *(const LAS bf16x8*)(lds + PG8_SB(b, h) + boff + n * 2048 + k * 1024); } while (0)
#define PG8_MMA(ai, bj, At, Bt) do { __builtin_amdgcn_s_setprio(1); _Pragma("unroll") for (int m = 0; m < 4; ++m) _Pragma("unroll") for (int n = 0; n < 2; ++n) _Pragma("unroll") for (int k = 0; k < 2; ++k) \
        acc[ai][bj][m][n] = __builtin_amdgcn_mfma_f32_16x16x32_bf16(Bt[n][k], At[m][k], acc[ai][bj][m][n], 0, 0, 0); __builtin_amdgcn_s_setprio(0); } while (0)
#define PG8_WAIT_V(n) asm volatile("s_waitcnt vmcnt(" #n ")" ::: "memory")
#define PG8_WAIT_L(n) asm volatile("s_waitcnt lgkmcnt(" #n ")" ::: "memory")
#define PG8_BAR __builtin_amdgcn_s_barrier()
#define PG8_SCHED __builtin_amdgcn_sched_barrier(0)
    Unit cur, nxt; int ui = 0;
    if (!S.next(0, cur)) return;
    f32x4 acc[2][2][4][2];
#pragma unroll
    for (int a = 0; a < 2; ++a)
#pragma unroll
        for (int b = 0; b < 2; ++b)
#pragma unroll
            for (int m = 0; m < 4; ++m)
#pragma unroll
                for (int n = 0; n < 2; ++n) acc[a][b][m][n] = (f32x4){0.f, 0.f, 0.f, 0.f};
    bf16x8 At[4][2], B0[2][2], B1[2][2];
    const char* cA = (const char*)gA_ + (size_t)cur.pm * tstep; const char* cB = (const char*)gB_ + (size_t)cur.pn * tstep;
    if constexpr (SP2) {
        PG8_STAGE(PG8_SB(0, 0), cB, voffB); PG8_STAGE(PG8_SB(0, 1), cB + hstep, voffB); PG8_STAGE(PG8_SA(0, 0), cA, voffA); PG8_STAGE(PG8_SA(0, 1), cA + hstep, voffA);
        if (wr == 1) PG8_BAR;
        PG8_WAIT_V(2); PG8_BAR;
        PG8_STAGE(PG8_SB(1, 0), cB + kstep, voffB); PG8_STAGE(PG8_SA(1, 0), cA + kstep, voffA); PG8_STAGE(PG8_SB(1, 1), cB + hstep + kstep, voffB);
        PG8_WAIT_V(6); PG8_BAR;
    } else {
        PG8_STAGE(PG8_SB(0, 0), cB, voffB); PG8_STAGE(PG8_SA(0, 0), cA, voffA); PG8_STAGE(PG8_SB(0, 1), cB + hstep, voffB); PG8_STAGE(PG8_SA(0, 1), cA + hstep, voffA);
        if (wr == 1) PG8_BAR;
        PG8_WAIT_V(4); PG8_BAR;
        PG8_STAGE(PG8_SB(1, 0), cB + kstep, voffB); PG8_STAGE(PG8_SA(1, 0), cA + kstep, voffA); PG8_STAGE(PG8_SB(1, 1), cB + hstep + kstep, voffB);
        PG8_WAIT_V(6); PG8_BAR;
    }
    for (;;) {
        const bool has_next = S.next(ui + 1, nxt);
        const char* nA = has_next ? (const char*)gA_ + (size_t)nxt.pm * tstep : cA; const char* nB = has_next ? (const char*)gB_ + (size_t)nxt.pn * tstep : cB;
        for (int t = 0; t < nt; t += 2) {
            const bool last = (t == nt - 2);
            const char* a1 = cA + (size_t)(t + 1) * kstep;
            const char* a2 = last ? nA : cA + (size_t)(t + 2) * kstep; const char* b2 = last ? nB : cB + (size_t)(t + 2) * kstep;
            const char* a3 = a2 + kstep; const char* b3 = b2 + kstep;
            if constexpr (SP2) {
            PG8_LDB(B0, 0, 0); PG8_LDB(B1, 0, 1); PG8_SCHED; PG8_LDA(At, 0, 0); PG8_STAGE(PG8_SA(1, 1), a1 + hstep, voffA);
            PG8_WAIT_V(8); PG8_WAIT_L(0); PG8_BAR; PG8_MMA(0, 0, At, B0); PG8_MMA(0, 1, At, B1); PG8_BAR; PG8_SCHED;
            PG8_LDA(At, 0, 1); PG8_STAGE(PG8_SB(0, 0), b2, voffB); PG8_STAGE(PG8_SB(0, 1), b2 + hstep, voffB); PG8_STAGE(PG8_SA(0, 0), a2, voffA);
            PG8_WAIT_V(8); PG8_WAIT_L(0); PG8_BAR; PG8_MMA(1, 0, At, B0); PG8_MMA(1, 1, At, B1); PG8_BAR; PG8_SCHED;
            PG8_LDB(B0, 1, 0); PG8_LDB(B1, 1, 1); PG8_SCHED; PG8_LDA(At, 1, 0); PG8_STAGE(PG8_SA(0, 1), a2 + hstep, voffA);
            PG8_WAIT_V(8); PG8_WAIT_L(0); PG8_BAR; PG8_MMA(0, 0, At, B0); PG8_MMA(0, 1, At, B1); PG8_BAR; PG8_SCHED;
            PG8_LDA(At, 1, 1); PG8_STAGE(PG8_SB(1, 0), b3, voffB); PG8_STAGE(PG8_SB(1, 1), b3 + hstep, voffB); PG8_STAGE(PG8_SA(1, 0), a3, voffA);
            PG8_WAIT_V(8); PG8_WAIT_L(0); PG8_BAR; PG8_MMA(1, 0, At, B0); PG8_MMA(1, 1, At, B1); PG8_BAR; PG8_SCHED;
            } else {
            PG8_LDB(B0, 0, 0); PG8_SCHED; PG8_LDA(At, 0, 0); PG8_STAGE(PG8_SA(1, 1), a1 + hstep, voffA);
            PG8_WAIT_L(8); PG8_BAR; PG8_WAIT_L(0); PG8_MMA(0, 0, At, B0); PG8_BAR; PG8_SCHED;
            PG8_LDB(B1, 0, 1); PG8_STAGE(PG8_SB(0, 0), b2, voffB);
            PG8_BAR; PG8_WAIT_L(0); PG8_MMA(0, 1, At, B1); PG8_BAR;
            PG8_LDA(At, 0, 1); PG8_STAGE(PG8_SA(0, 0), a2, voffA);
            PG8_BAR; PG8_WAIT_L(0); PG8_MMA(1, 0, At, B0); PG8_BAR; PG8_SCHED;
            PG8_STAGE(PG8_SB(0, 1), b2 + hstep, voffB);
            PG8_WAIT_V(6); PG8_BAR; PG8_MMA(1, 1, At, B1); PG8_BAR;
            PG8_LDB(B0, 1, 0); PG8_SCHED; PG8_LDA(At, 1, 0); PG8_STAGE(PG8_SA(0, 1), a2 + hstep, voffA);
            PG8_WAIT_L(8); PG8_BAR; PG8_WAIT_L(0); PG8_MMA(0, 0, At, B0); PG8_BAR; PG8_SCHED;
            PG8_LDB(B1, 1, 1); PG8_STAGE(PG8_SB(1, 0), b3, voffB);
            PG8_BAR; PG8_WAIT_L(0); PG8_MMA(0, 1, At, B1); PG8_BAR;
            PG8_LDA(At, 1, 1); PG8_STAGE(PG8_SA(1, 0), a3, voffA);
            PG8_BAR; PG8_WAIT_L(0); PG8_MMA(1, 0, At, B0); PG8_BAR; PG8_SCHED;
            PG8_STAGE(PG8_SB(1, 1), b3 + hstep, voffB);
            PG8_WAIT_V(6); PG8_BAR; PG8_MMA(1, 1, At, B1); PG8_BAR;
            }
        }
        if constexpr (ALIGN_EPI) { if (wr == 0) PG8_BAR; }
        if constexpr (!Epi::AFTER_DRAIN) { if constexpr (Epi::FUSED_MID) E.fused(acc, cur, wr, wc, fr, fq, lds, wid, lane); else E(acc, cur, wr, wc, fr, fq); }
        if (!has_next) break;
#pragma unroll
        for (int a = 0; a < 2; ++a)
#pragma unroll
            for (int b = 0; b < 2; ++b)
#pragma unroll
                for (int m = 0; m < 4; ++m)
#pragma unroll
                    for (int n = 0; n < 2; ++n) acc[a][b][m][n] = (f32x4){0.f, 0.f, 0.f, 0.f};
        cur = nxt; cA = nA; cB = nB; ++ui;
        if constexpr (ALIGN_EPI) { if (wr == 1) PG8_BAR; }
    }
    PG8_WAIT_V(0);
    if constexpr (!ALIGN_EPI) { if (wr == 0) PG8_BAR; }
    PG8_BAR;
    if constexpr (Epi::AFTER_DRAIN) E.fused(acc, cur, wr, wc, fr, fq, lds, wid, lane);
#undef PG8_SA
#undef PG8_SB
#undef PG8_STAGE
#undef PG8_LDA
#undef PG8_LDB
#undef PG8_MMA
#undef PG8_WAIT_V
#undef PG8_WAIT_L
#undef PG8_BAR
#undef PG8_SCHED
}
}

namespace att {
constexpr int KCH = 1040, KSLOT = 8 * KCH  , KOFF = 0, VOFF_S = 16384, VOFF_B = 6 * KSLOT  , WSF = VOFF_B + 6 * 8192, OST = WSF + 4096, KM = OST + 32768, ATT_LDS = KM + 4096;
__device__ __forceinline__ int crow(int r, int hi) { return (r & 3) + 8 * (r >> 2) + 4 * hi; }
__device__ __forceinline__ float xhalf_max(float m) { auto rr = __builtin_amdgcn_permlane32_swap(__float_as_uint(m), __float_as_uint(m), false, false); return fmaxf(__uint_as_float(rr[0]), __uint_as_float(rr[1])); }
__device__ __forceinline__ float xhalf_sum(float m) { auto rr = __builtin_amdgcn_permlane32_swap(__float_as_uint(m), __float_as_uint(m), false, false); return __uint_as_float(rr[0]) + __uint_as_float(rr[1]); }
__device__ __forceinline__ s16x4 vtr(const LAS unsigned char* p) { return __builtin_bit_cast(s16x4, __builtin_amdgcn_ds_read_tr16_b64_v4i16((LAS s16x4*)p)); }
struct State { float mref, lsum; f32x16 o0, o1; };

__device__ __forceinline__ void tile_s(const LAS unsigned char* kb, const bf16x8 (&qr)[4], f32x16& p0, f32x16& p1) {
    {
        const f32x16 z = {0.f, 0.f, 0.f, 0.f, 0.f, 0.f, 0.f, 0.f, 0.f, 0.f, 0.f, 0.f, 0.f, 0.f, 0.f, 0.f};
        const bf16x8 a0 = *(const LAS bf16x8*)(kb), a1 = *(const LAS bf16x8*)(kb + 512);
        p0 = __builtin_amdgcn_mfma_f32_32x32x16_bf16(a0, qr[0], z, 0, 0, 0);
        p1 = __builtin_amdgcn_mfma_f32_32x32x16_bf16(a1, qr[0], z, 0, 0, 0);
    }
#pragma unroll
    for (int d0 = 1; d0 < 4; ++d0) {
        const bf16x8 a0 = *(const LAS bf16x8*)(kb + d0 * 2 * KCH), a1 = *(const LAS bf16x8*)(kb + d0 * 2 * KCH + 512);
        p0 = __builtin_amdgcn_mfma_f32_32x32x16_bf16(a0, qr[d0], p0, 0, 0, 0);
        p1 = __builtin_amdgcn_mfma_f32_32x32x16_bf16(a1, qr[d0], p1, 0, 0, 0);
    }
}
template <int MODE>
__device__ __forceinline__ void tile_finish(f32x16& p0, f32x16& p1, const LAS unsigned char* vp, State& st, LAS float* wsf, int r32, int hi, int k0, int qi, bool full, bool past, bool bit) {
    constexpr int NB = (MODE == 0) ? 127 : 128;
    if (__any(st.mref != 0.f)) {
#pragma unroll
        for (int r = 0; r < 16; ++r) { p0[r] -= st.mref; p1[r] -= st.mref; }
    }
    if (!full) {
        if (MODE == 2 && past) {
        } else {
#pragma unroll
            for (int r = 0; r < 16; ++r) {
                const int kk = k0 + crow(r, hi);
                bool ok0 = (kk <= qi), ok1 = (kk + 32 <= qi);
                if (MODE != 2) { ok0 = ok0 && (kk >= qi - NB); ok1 = ok1 && (kk + 32 >= qi - NB); }
                if (!ok0) p0[r] = -INFINITY;
                if (!ok1) p1[r] = -INFINITY;
            }
        }
    }
    float rm = fmaxf(p0[0], p1[0]);
#pragma unroll
    for (int r = 1; r < 16; ++r) rm = __builtin_fmaxf(__builtin_fmaxf(rm, p0[r]), p1[r]);
    rm = xhalf_max(rm);
    if (__any(rm > 8.0f)) {
        const float dl = fmaxf(rm, 0.f);
        st.mref += dl;
#pragma unroll
        for (int r = 0; r < 16; ++r) { p0[r] -= dl; p1[r] -= dl; }
        const float f = __builtin_amdgcn_exp2f(-dl);
        st.lsum *= f;
        if (hi == 0) wsf[r32] = f;
        asm volatile("s_waitcnt lgkmcnt(0)" ::: "memory");
#pragma unroll
        for (int r = 0; r < 16; ++r) { const float fr_ = wsf[crow(r, hi)]; st.o0[r] *= fr_; st.o1[r] *= fr_; }
        asm volatile("s_waitcnt lgkmcnt(0)" ::: "memory");
    }
#pragma unroll
    for (int r = 0; r < 16; ++r) { p0[r] = __builtin_amdgcn_exp2f(p0[r]); p1[r] = __builtin_amdgcn_exp2f(p1[r]); }
    float ps;
    { const f32x16 sv = p0 + p1; const f32x4 s4 = (f32x4){sv[0], sv[1], sv[2], sv[3]} + (f32x4){sv[4], sv[5], sv[6], sv[7]} + (f32x4){sv[8], sv[9], sv[10], sv[11]} + (f32x4){sv[12], sv[13], sv[14], sv[15]};
      ps = (s4[0] + s4[1]) + (s4[2] + s4[3]); }
    u32x4 pw[4];
#pragma unroll
    for (int j = 0; j < 4; ++j) { pw[0][j] = cvtpk(p0[2 * j], p0[2 * j + 1]); pw[1][j] = cvtpk(p0[8 + 2 * j], p0[9 + 2 * j]); pw[2][j] = cvtpk(p1[2 * j], p1[2 * j + 1]); pw[3][j] = cvtpk(p1[8 + 2 * j], p1[9 + 2 * j]); }
    if (MODE == 2 && past && !full) {
        const unsigned km = bit ? 0xffffffffu : 0u;
#pragma unroll
        for (int k = 0; k < 4; ++k) { pw[k][0] &= km; pw[k][1] &= km; pw[k][2] &= km; pw[k][3] &= km; }
        ps = bit ? ps : 0.f;
    }
    st.lsum += ps;
#pragma unroll
    for (int ks = 0; ks < 4; ++ks) {
        const bf16x8 pa = __builtin_bit_cast(bf16x8, pw[ks]);
        { const s16x4 lo = vtr(vp + ks * 1024), hh = vtr(vp + ks * 1024 + 512);
          const bf16x8 vb = {lo[0], lo[1], lo[2], lo[3], hh[0], hh[1], hh[2], hh[3]};
          st.o0 = __builtin_amdgcn_mfma_f32_32x32x16_bf16(pa, vb, st.o0, 0, 0, 0); }
        { const s16x4 lo = vtr(vp + 4096 + ks * 1024), hh = vtr(vp + 4096 + ks * 1024 + 512);
          const bf16x8 vb = {lo[0], lo[1], lo[2], lo[3], hh[0], hh[1], hh[2], hh[3]};
          st.o1 = __builtin_amdgcn_mfma_f32_32x32x16_bf16(pa, vb, st.o1, 0, 0, 0); }
    }
}
template <int MODE, bool PIPE>
__device__ __forceinline__ void run_range(LAS unsigned char* lds, int ta, int tb, int slot_base, int kro, int vro, const bf16x8 (&qr)[4], State& st, LAS float* wsf, int r32, int hi,
                                          int q0w, int qi, bool past, bool bit, bool full_past) {
    constexpr int NB = (MODE == 0) ? 127 : 128;
    if (ta >= tb) return;
#define RR_KB(t) (lds + KOFF + ((t) - slot_base) * KSLOT + kro)
#define RR_VP(t) (lds + VOFF_B + ((t) - slot_base) * 8192 + vro)
#define RR_FULL(t) (past ? full_past : ((MODE == 2) ? (64 * (t) + 63 <= q0w) : ((64 * (t) + 63 <= q0w) && (q0w + 31 - 64 * (t) <= NB))))
    f32x16 a0, a1, b0, b1;
    if constexpr (!PIPE) {
        for (int t = ta; t < tb; ++t) { tile_s(RR_KB(t), qr, a0, a1); tile_finish<MODE>(a0, a1, RR_VP(t), st, wsf, r32, hi, 64 * t, qi, RR_FULL(t), past, bit); }
        return;
    }
    tile_s(RR_KB(ta), qr, a0, a1);
    int t = ta;
    for (;;) {
        if (t + 1 < tb) tile_s(RR_KB(t + 1), qr, b0, b1);
        tile_finish<MODE>(a0, a1, RR_VP(t), st, wsf, r32, hi, 64 * t, qi, RR_FULL(t), past, bit);
        if (++t >= tb) break;
        if (t + 1 < tb) tile_s(RR_KB(t + 1), qr, a0, a1);
        tile_finish<MODE>(b0, b1, RR_VP(t), st, wsf, r32, hi, 64 * t, qi, RR_FULL(t), past, bit);
        if (++t >= tb) break;
    }
#undef RR_KB
#undef RR_VP
#undef RR_FULL
}
template <int MODE>
__device__ __forceinline__ void epilogue(LAS unsigned char* lds, State& st, int wid, int lane, bf16_t* Ow, long ostride, int q0w, float sink2, float* lse_w, long lse_stride, int grp) {
    const int r32 = lane & 31, hi = lane >> 5;
    LAS float* wsf = (LAS float*)(lds + WSF) + wid * 128;
    float lsum = xhalf_sum(st.lsum);
    if constexpr (MODE == 0) lsum += __builtin_amdgcn_exp2f(sink2 - st.mref);
    if (hi == 0) { wsf[r32] = __builtin_amdgcn_rcpf(lsum); wsf[32 + r32] = st.mref + __builtin_amdgcn_logf(lsum); }
    asm volatile("s_waitcnt lgkmcnt(0)" ::: "memory");
    LAS bf16_t* stg = (LAS bf16_t*)(lds + OST) + wid * 2048;
#pragma unroll
    for (int r = 0; r < 16; ++r) {
        const int orow = crow(r, hi); const float il = wsf[orow];
        stg[orow * 64 + r32] = (bf16_t)(cvtpk(st.o0[r] * il, 0.f) & 0xffffu);
        stg[orow * 64 + 32 + r32] = (bf16_t)(cvtpk(st.o1[r] * il, 0.f) & 0xffffu);
    }
    asm volatile("s_waitcnt lgkmcnt(0)" ::: "memory");
#pragma unroll
    for (int i = 0; i < 4; ++i) {
        const int row = i * 8 + (lane >> 3), ch = lane & 7;
        u32x4 v = *(const LAS u32x4*)(stg + row * 64 + ch * 8);
        bf16_t* op = Ow + (long)(q0w + row) * ostride + ch * 8;
        if constexpr (MODE == 1) {
            float* lp = lse_w + (long)(q0w + row) * lse_stride;
            const float lb = wsf[32 + row];
            if (grp > 0) {
                const float la = *lp; const u32x4 ov = *(const u32x4*)op;
                const float L = fmaxf(la, lb), wa = __builtin_amdgcn_exp2f(la - L), wb = __builtin_amdgcn_exp2f(lb - L), inv = __builtin_amdgcn_rcpf(wa + wb);
                const float ca = wa * inv, cb = wb * inv;
#pragma unroll
                for (int j = 0; j < 4; ++j) {
                    const float a_lo = __uint_as_float(ov[j] << 16), a_hi = __uint_as_float(ov[j] & 0xffff0000u);
                    const float b_lo = __uint_as_float(v[j] << 16), b_hi = __uint_as_float(v[j] & 0xffff0000u);
                    v[j] = cvtpk(ca * a_lo + cb * b_lo, ca * a_hi + cb * b_hi);
                }
                if (ch == 0) *lp = L + __builtin_amdgcn_logf(wa + wb);
            } else if (ch == 0) *lp = lb;
        }
        *(u32x4*)op = v;
    }
    asm volatile("s_waitcnt lgkmcnt(0)" ::: "memory");
}

__device__ __forceinline__ void moba_unit(LAS unsigned char* lds, const bf16_t* Qw, const bf16_t* Kp, const bf16_t* Vp, bf16_t* Ow, int q0w, int blk_i, const float* km_bh) {
    int tid_ = threadIdx.x; asm volatile("" : "+v"(tid_));
    const int tid = tid_, lane = tid & 63, r32 = lane & 31, hi = lane >> 5;
    const int wid = __builtin_amdgcn_readfirstlane(tid >> 6);
    const int lkey = tid >> 3, lch = tid & 7;
    constexpr long kstride = 3072, qstride = 3072;
    const int t_hi = 4 * blk_i + 4;
    const bf16_t* kg = Kp + (long)lkey * kstride + lch * 8;
    const bf16_t* vg = Vp + (long)lkey * kstride + lch * 8;
    u32x4 kreg4[4], vreg4[4];
#pragma unroll
    for (int s_ = 0; s_ < 4; ++s_) { kreg4[s_] = *(const u32x4*)(kg + (long)(64 * s_) * kstride); vreg4[s_] = *(const u32x4*)(vg + (long)(64 * s_) * kstride); }
    bf16x8 qr[4];
    { const bf16_t* qp = Qw + (long)(q0w + r32) * qstride + hi * 8;
#pragma unroll
      for (int d0 = 0; d0 < 4; ++d0) qr[d0] = *(const bf16x8*)(qp + d0 * 16); }
    const int qi = q0w + r32;
    unsigned sel = 0u;
    {
        LAS float* km = (LAS float*)(lds + KM);
        { const int n = tid >> 5, d2 = (tid & 31) * 2; const f32x2 v = *(const f32x2*)(km_bh + (long)n * 1024 + d2); *(LAS f32x2*)(km + n * 64 + d2) = v; }
        __syncthreads();
        float v0 = -INFINITY, v1 = -INFINITY, v2 = -INFINITY; int i0 = 0, i1 = 0, i2 = 0;
        for (int n = 0; n < blk_i; ++n) {
            float s = 0.f;
#pragma unroll
            for (int d0 = 0; d0 < 4; ++d0) {
                const f32x4 ka = *(const LAS f32x4*)(km + n * 64 + d0 * 16 + hi * 8), kb = *(const LAS f32x4*)(km + n * 64 + d0 * 16 + hi * 8 + 4);
#pragma unroll
                for (int j = 0; j < 4; ++j) { s += bf2f((unsigned short)qr[d0][j]) * ka[j]; s += bf2f((unsigned short)qr[d0][4 + j]) * kb[j]; }
            }
            s = xhalf_sum(s);
            if (s > v0) { v2 = v1; i2 = i1; v1 = v0; i1 = i0; v0 = s; i0 = n; }
            else if (s > v1) { v2 = v1; i2 = i1; v1 = s; i1 = n; }
            else if (s > v2) { v2 = s; i2 = n; }
        }
        sel = (blk_i >= 1 ? (1u << i0) : 0u) | (blk_i >= 2 ? (1u << i1) : 0u) | (blk_i >= 3 ? (1u << i2) : 0u);
    }
    const unsigned kw = lch * KCH + lkey * 16, vw = (lch >> 2) * 4096 + lkey * 64 + (lch & 3) * 16;
    State st; st.mref = 0.f; st.lsum = 0.f;
#pragma unroll
    for (int r = 0; r < 16; ++r) { st.o0[r] = 0.f; st.o1[r] = 0.f; }
    LAS float* wsf = (LAS float*)(lds + WSF) + wid * 128;
    const int kro = hi * KCH + r32 * 16;
    const int vro = ((lane >> 4) & 1) * 32 + (lane & 3) * 8 + (4 * hi + ((lane & 15) >> 2)) * 64;
    for (int jb = 0; jb <= blk_i; ++jb) {
#pragma unroll
        for (int s_ = 0; s_ < 4; ++s_) { *(LAS u32x4*)(lds + KOFF + s_ * KSLOT + kw) = kreg4[s_]; *(LAS u32x4*)(lds + VOFF_B + s_ * 8192 + vw) = vreg4[s_]; }
        __syncthreads();
        if (jb < blk_i) {
#pragma unroll
            for (int s_ = 0; s_ < 4; ++s_) { kreg4[s_] = *(const u32x4*)(kg + (long)(64 * (4 * (jb + 1) + s_)) * kstride); vreg4[s_] = *(const u32x4*)(vg + (long)(64 * (4 * (jb + 1) + s_)) * kstride); }
        }
        const bool past = jb < blk_i;
        bool bit = true, need_blk = true, full_blk = false;
        if (past) { bit = (sel >> jb) & 1u; need_blk = __any(bit); full_blk = !__any(!bit); }
        if (need_blk) {
            const int tb = past ? 4 * jb + 4 : ((q0w + 31) >> 6) + 1;
            run_range<2, true>(lds, 4 * jb, tb, 4 * jb, kro, vro, qr, st, wsf, r32, hi, q0w, qi, past, bit, full_blk);
        }
        __syncthreads();
    }
    epilogue<2>(lds, st, wid, lane, Ow, DM, q0w, 0.f, nullptr, 0, 0);
}

template <int MODE>
__device__ __forceinline__ void banded_phase(LAS unsigned char* lds, int vc, const bf16_t* QKV, bf16_t* OB, float* LSE, const float* sinks, int pass) {
    constexpr int NT = (MODE == 0) ? 3 : 6, NB = (MODE == 0) ? 127 : 128;
    int tid_ = threadIdx.x; asm volatile("" : "+v"(tid_));
    const int tid = tid_, lane = tid & 63, r32 = lane & 31, hi = lane >> 5;
    const int wid = __builtin_amdgcn_readfirstlane(tid >> 6);
    const int lkey = tid >> 3, lch = tid & 7;
    const int dil = (MODE == 0) ? 1 : ((pass == 0) ? 1 : (pass == 1) ? 4 : 16);
    const long ld = (MODE == 0) ? 1536 : 3072;
    const long kstride = (long)dil * ld;
    const unsigned kw = lch * KCH + lkey * 16, vw = (lch >> 2) * 4096 + lkey * 64 + (lch & 3) * 16;
    const int kro = hi * KCH + r32 * 16;
    const int vro = ((lane >> 4) & 1) * 32 + (lane & 3) * 8 + (4 * hi + ((lane & 15) >> 2)) * 64;
    LAS float* wsf = (LAS float*)(lds + WSF) + wid * 128;
    u32x4 kreg[NT], vreg[NT]; bf16x8 qn[4];
#define UNIT_DECODE(k) \
    const int u_ = vc * 8 + (k); const int b_ = u_ >> 8; \
    int hq_, hkv_, r_, q0_, thi_; \
    if (MODE == 0) { const int kvh = (u_ >> 6) & 3, qt = u_ & 63; hq_ = 4 * kvh + (wid >> 1); hkv_ = kvh; r_ = 0; q0_ = 64 * qt + 32 * (wid & 1); thi_ = qt + 1; } \
    else { const int xx = u_ & 15; hq_ = (u_ >> 4) & 15; hkv_ = hq_; r_ = xx % dil; const int jt = xx / dil; q0_ = 256 * jt + 32 * wid; thi_ = 4 * jt + 4; } \
    const bf16_t* base_ = QKV + ((size_t)b_ * SEQ + r_) * ld;
#define UNIT_LOAD(k) do { UNIT_DECODE(k) \
    const bf16_t* kg_ = base_ + 1024 + hkv_ * 64 + (long)lkey * kstride + lch * 8; const bf16_t* vg_ = kg_ + ((MODE == 0) ? 256 : 1024); \
    _Pragma("unroll") for (int s_ = 0; s_ < NT; ++s_) { int t_ = thi_ - NT + s_; t_ = t_ < 0 ? 0 : t_; kreg[s_] = *(const u32x4*)(kg_ + (long)(64 * t_) * kstride); vreg[s_] = *(const u32x4*)(vg_ + (long)(64 * t_) * kstride); } \
    const bf16_t* qp_ = base_ + hq_ * 64 + (long)(q0_ + r32) * kstride + hi * 8; \
    _Pragma("unroll") for (int d0 = 0; d0 < 4; ++d0) qn[d0] = *(const bf16x8*)(qp_ + d0 * 16); } while (0)
    UNIT_LOAD(0);
    for (int k = 0; k < 8; ++k) {
#pragma unroll
        for (int s_ = 0; s_ < NT; ++s_) { *(LAS u32x4*)(lds + KOFF + s_ * KSLOT + kw) = kreg[s_]; *(LAS u32x4*)(lds + VOFF_B + s_ * 8192 + vw) = vreg[s_]; }
        bf16x8 qr[4];
#pragma unroll
        for (int d0 = 0; d0 < 4; ++d0) qr[d0] = qn[d0];
        __syncthreads();
        if (k + 1 < 8) UNIT_LOAD(k + 1);
        UNIT_DECODE(k)
        const int qi = q0_ + r32, tlo = (thi_ - NT) < 0 ? 0 : (thi_ - NT);
        State st; st.mref = 0.f; st.lsum = 0.f;
#pragma unroll
        for (int r = 0; r < 16; ++r) { st.o0[r] = 0.f; st.o1[r] = 0.f; }
        {
            int ta = (q0_ - NB) >> 6; ta = ta < tlo ? tlo : ta;
            int tb = ((q0_ + 31) >> 6) + 1; tb = tb > thi_ ? thi_ : tb;
            run_range<MODE, MODE == 0>(lds, ta, tb, thi_ - NT, kro, vro, qr, st, wsf, r32, hi, q0_, qi, false, true, false);
        }
        float sink2 = 0.f; if (MODE == 0) sink2 = sinks[hq_] * LOG2E;
        epilogue<MODE>(lds, st, wid, lane, OB + ((size_t)b_ * SEQ + r_) * DM + hq_ * 64, (long)dil * DM, q0_, sink2, LSE + ((size_t)b_ * SEQ + r_) * 16 + hq_, (long)dil * 16, pass);
        __syncthreads();
    }
#undef UNIT_LOAD
#undef UNIT_DECODE
}
}

constexpr size_t MiB = 1u << 20;
constexpr size_t WS_W = 8 * MiB, WS_XN = 112 * MiB, WS_O = 176 * MiB, WS_LSE = 240 * MiB, WS_KM = 242 * MiB, WS_ROPE = 243 * MiB, WS_QKV = 246 * MiB, WS_END = 502 * MiB;
constexpr size_t W_AQKV = 0, W_AO = 3145728, W_BQKV = 5242880, W_BO = 14680064, W_CQKV = 15728640, W_CO = 18874368, W_GU = 19922944, W_DN = 42991616, W_TOTAL = 54525952;
static_assert(WS_W + W_TOTAL * 2 <= WS_XN, "weights region");
constexpr int LDS_BYTES = 147456;
static_assert(att::ATT_LDS <= 143360 && pg8::STAGE_BYTES + 8192 + 2048 <= 143360, "phase LDS below the barrier's two set-up words");

struct Args { const void* in[15]; float* out; unsigned char* ws; int ph_lo, ph_hi; };

__device__ __forceinline__ float wave_sum(float v) {
#pragma unroll
    for (int o = 1; o < 64; o <<= 1) v += __shfl_xor(v, o);
    return v;
}
__device__ __forceinline__ int rope_perm32(int l) { return (l < 16) ? ((l >> 1) + 8 * (l & 1)) : l; }
__device__ __forceinline__ void transpose_item(const float* W, int K, int Nsrc, bf16_t* WT, int k0, int ns0, int nd0, LAS float* scr, int lane, bool rperm) {
    const int sl = rperm ? rope_perm32(lane & 31) : (lane & 31);
    float tv[32];
    const float* wp = W + (size_t)(k0 + (lane >> 5)) * Nsrc + ns0 + sl;
#pragma unroll
    for (int i = 0; i < 32; ++i) tv[i] = wp[(size_t)(2 * i) * Nsrc];
#pragma unroll
    for (int i = 0; i < 32; ++i) scr[(2 * i + (lane >> 5)) * 33 + (lane & 31)] = tv[i];
    asm volatile("s_waitcnt lgkmcnt(0)" ::: "memory");
    const int c = lane & 7;
#pragma unroll
    for (int j = 0; j < 4; ++j) { const int n = (lane >> 3) + 8 * j; const LAS float* s = scr + (8 * c) * 33 + n;
        u32x4 o; o.x = cvtpk(s[0 * 33], s[1 * 33]); o.y = cvtpk(s[2 * 33], s[3 * 33]); o.z = cvtpk(s[4 * 33], s[5 * 33]); o.w = cvtpk(s[6 * 33], s[7 * 33]);
        *(u32x4*)(WT + (size_t)(nd0 + n) * K + k0 + 8 * c) = o; }
    asm volatile("s_waitcnt lgkmcnt(0)" ::: "memory");
}
__device__ __forceinline__ bool transpose_family(int& r, const float* src, bf16_t* dst, int nmat, int K, int N, bool gu, LAS float* scr, int lane, int rope_mode = 0) {
    const int nblk = N / 32, per = (K / 64) * nblk, tot = nmat * per;
    if (r >= tot) { r -= tot; return false; }
    const int mat = r / per, it = r % per, kb = it / nblk, nb = it % nblk;
    const int nd0 = 32 * nb; int ns0 = nd0;
    if (gu) { const int tile = nd0 >> 8, within = nd0 & 255; ns0 = (within >> 7) * DFF + tile * 128 + (within & 127); }
    const bool rperm = ((nd0 & 63) == 0) && ((rope_mode == 1 && nd0 < 1280) || (rope_mode == 2 && (nd0 % 3072) < 2048));
    transpose_item(src + (size_t)mat * K * N, K, N, dst + (size_t)mat * K * N, 64 * kb, ns0, nd0, scr, lane, rperm);
    return true;
}
__device__ __forceinline__ void sincos_tab(float ang, float& c, float& s) {
    const double a = (double)ang; const double n = __builtin_rint(a * 0.63661977236758134308);
    double r = __builtin_fma(-n, 1.57079632679489655800, a); r = __builtin_fma(-n, 6.12323399573676603587e-17, r);
    const float x = (float)r, x2 = x * x;
    const float sp = x * (1.f + x2 * (-1.6666667163e-1f + x2 * (8.3333337680e-3f + x2 * (-1.9841270114e-4f + x2 * 2.7557314297e-6f))));
    const float cp = 1.f + x2 * (-0.5f + x2 * (4.1666667908e-2f + x2 * (-1.3888889225e-3f + x2 * (2.4801587642e-5f + x2 * (-2.7557314297e-7f)))));
    const int q = ((int)n) & 3;
    const float ss = (q & 1) ? cp : sp, cc = (q & 1) ? sp : cp;
    s = (q & 2) ? -ss : ss; c = ((q + 1) & 2) ? -cc : cc;
}

#define XB_TMO      128
#define XB_XCNT(j)  (256  + 64 * (j))
#define XB_XSUB(j)  (1280 + 64 * (j))
#define XB_XGEN(j)  (2304 + 64 * (j))
#define XB_TOP      3328
#define XB_TOPGEN   3392
#define XCD_BAR_WORDS 3456
#define XB_SPIN_CAP (1u << 22)
__device__ __forceinline__ unsigned xb_ld(unsigned* p)              { return __hip_atomic_load(p, __ATOMIC_RELAXED, __HIP_MEMORY_SCOPE_AGENT); }
__device__ __forceinline__ unsigned xb_add(unsigned* p, unsigned v) { return __hip_atomic_fetch_add(p, v, __ATOMIC_RELAXED, __HIP_MEMORY_SCOPE_AGENT); }
__device__ __forceinline__ unsigned xb_xcc_id() { return (unsigned)__builtin_amdgcn_s_getreg((3 << 11) | 20) & 0xFu; }
#define XB_SPIN(cond, bar) do { unsigned _sp = 0; while (cond) { __builtin_amdgcn_s_sleep(1); \
    if ((++_sp & 255u) == 0u) { if (xb_ld(&(bar)[XB_TMO])) break; if (_sp > XB_SPIN_CAP) { atomicAdd(&(bar)[XB_TMO], 1u); break; } } } } while (0)
struct XcdBarrier { unsigned* bar; unsigned x; volatile LAS unsigned* st; };
__device__ __forceinline__ XcdBarrier xcd_barrier_post(unsigned* bar, volatile LAS unsigned* st) {
    XcdBarrier b; b.bar = bar; b.x = xb_xcc_id(); b.st = st;
    if (threadIdx.x == 0) (void)xb_add(&bar[XB_XCNT(b.x)], 1u);
    return b;
}
__device__ __forceinline__ void xcd_barrier_complete(unsigned* bar, unsigned x, unsigned& nloc, unsigned& nx) {
    const unsigned G = gridDim.x * gridDim.y * gridDim.z;
    unsigned sum, cnt, mine, sp = 0u;
    for (;;) {
        sum = 0u; cnt = 0u; mine = 0u;
#pragma unroll
        for (unsigned j = 0; j < 16; ++j) { const unsigned c = xb_ld(&bar[XB_XCNT(j)]); sum += c; cnt += (c > 0u) ? 1u : 0u; mine = (j == x) ? c : mine; }
        if (sum == G) break;
        __builtin_amdgcn_s_sleep(1);
        if ((++sp & 255u) == 0u) { if (xb_ld(&bar[XB_TMO])) break; if (sp > XB_SPIN_CAP) { atomicAdd(&bar[XB_TMO], 1u); break; } }
    }
    nloc = mine > 0u ? mine : 1u; nx = cnt > 0u ? cnt : 1u;
}
__device__ __forceinline__ void xcd_barrier(const XcdBarrier& b) {
    asm volatile("s_waitcnt vmcnt(0)" ::: "memory");
    __syncthreads();
    if (threadIdx.x == 0) {
        unsigned* bar = b.bar;
        __builtin_amdgcn_s_waitcnt(0);
        unsigned nloc = b.st[0], nx = b.st[1];
        if (nloc == 0u) { xcd_barrier_complete(bar, b.x, nloc, nx); b.st[0] = nloc; b.st[1] = nx; }
        const unsigned old = xb_add(&bar[XB_XSUB(b.x)], 1u);
        const unsigned gen = old / nloc;
        if (old + 1u == (gen + 1u) * nloc) {
            __builtin_amdgcn_fence(__ATOMIC_RELEASE, "agent");
            asm volatile("s_waitcnt vmcnt(0)" ::: "memory");
            const unsigned og = xb_add(&bar[XB_TOP], 1u);
            const unsigned tg = og / nx;
            if (og + 1u == (tg + 1u) * nx) xb_add(&bar[XB_TOPGEN], 1u);
            else XB_SPIN(xb_ld(&bar[XB_TOPGEN]) == tg, bar);
            __builtin_amdgcn_fence(__ATOMIC_ACQUIRE, "agent");
            xb_add(&bar[XB_XGEN(b.x)], 1u);
            asm volatile("s_waitcnt vmcnt(0)" ::: "memory");
        } else {
            XB_SPIN(xb_ld(&bar[XB_XGEN(b.x)]) == gen, bar);
            __builtin_amdgcn_fence(__ATOMIC_ACQUIRE, "agent");
            asm volatile("s_waitcnt vmcnt(0)" ::: "memory");
        }
    }
    __syncthreads();
}
constexpr int MISC_OFF = 143360;

__global__ void __launch_bounds__(512, 2) mega(Args args) {
    extern __shared__ __attribute__((aligned(16))) unsigned char lds_raw[];
    LAS unsigned char* lds = (LAS unsigned char*)lds_raw;
    cg::grid_group grid = cg::this_grid();
    const int tid0 = threadIdx.x, wave = __builtin_amdgcn_readfirstlane(tid0 >> 6);
#define LTID() int tid = threadIdx.x; asm volatile("" : "+v"(tid)); const int lane = tid & 63; (void)lane
    const int G = gridDim.x, bx = blockIdx.x;
    const int vcu = (G % 8 == 0) ? (bx % 8) * (G / 8) + bx / 8 : bx;
    const int gw = vcu * 8 + wave, NGW = G * 8;
    unsigned char* ws = args.ws;
    const float* x_in = (const float*)args.in[0]; const int* positions = (const int*)args.in[1];
    const float* ln_g = (const float*)args.in[2]; const float* ln_b = (const float*)args.in[3];
    float* out = args.out;
    bf16_t* Wb = (bf16_t*)(ws + WS_W); bf16_t* XN = (bf16_t*)(ws + WS_XN); bf16_t* OB = (bf16_t*)(ws + WS_O);
    float* LSE = (float*)(ws + WS_LSE); float* KMEAN = (float*)(ws + WS_KM); float* ROPE = (float*)(ws + WS_ROPE);
    bf16_t* QKV = (bf16_t*)(ws + WS_QKV); bf16_t* HB = QKV;
    float* BIASP = (float*)(ws + 3 * MiB);
    bf16_t* XLO = (bf16_t*)(ws + 438 * MiB);
    unsigned* CNT = (unsigned*)(ws + 1 * MiB); unsigned long long* XBUF = (unsigned long long*)(ws + 2 * MiB);
    const int lo = args.ph_lo, hi = args.ph_hi;
    int ph = 0;
    unsigned* BARW = (unsigned*)ws;
    if (tid0 < 2) ((volatile LAS unsigned*)(lds + MISC_OFF))[tid0] = 0u;
    if (bx == 0) { for (int i = tid0; i < XCD_BAR_WORDS; i += 512) __hip_atomic_store(BARW + i, 0u, __ATOMIC_RELAXED, __HIP_MEMORY_SCOPE_AGENT); }
    __syncthreads();
    XcdBarrier xbar; xbar.bar = BARW; xbar.x = 0; xbar.st = (volatile LAS unsigned*)(lds + MISC_OFF);
#define RUN() (ph >= lo && ph < hi)
#define SEAM() do { if (ph + 1 < hi) { if (ph == 0) { grid.sync(); xbar = xcd_barrier_post(BARW, (volatile LAS unsigned*)(lds + MISC_OFF)); } else xcd_barrier(xbar); } } while (0)

    if (RUN()) {
        LTID();
        LAS float* scr = (LAS float*)(lds + wave * 16384);
        constexpr int NITEMS = (int)(W_TOTAL / 2048);
        for (int it = gw; it < NITEMS; it += NGW) {
            int r = it;
            if (transpose_family(r, (const float*)args.in[4], Wb + W_AQKV, 2, DM, 1536, false, scr, lane, 1)) continue;
            if (transpose_family(r, (const float*)args.in[7], Wb + W_AO, 2, DM, DM, false, scr, lane)) continue;
            if (transpose_family(r, (const float*)args.in[9], Wb + W_BQKV, 1, DM, 9216, false, scr, lane, 2)) continue;
            if (transpose_family(r, (const float*)args.in[10], Wb + W_BO, 1, DM, DM, false, scr, lane)) continue;
            if (transpose_family(r, (const float*)args.in[11], Wb + W_CQKV, 1, DM, 3072, false, scr, lane, 2)) continue;
            if (transpose_family(r, (const float*)args.in[12], Wb + W_CO, 1, DM, DM, false, scr, lane)) continue;
            if (transpose_family(r, (const float*)args.in[13], Wb + W_GU, 4, DM, 2 * DFF, true, scr, lane)) continue;
            transpose_family(r, (const float*)args.in[14], Wb + W_DN, 4, DFF, DM, false, scr, lane);
        }
        for (int m = gw; m < MTOK; m += NGW) {
            const f32x4* xr = (const f32x4*)(x_in + (size_t)m * DM) + lane; u32x2* o8 = (u32x2*)(XN + (size_t)m * DM) + lane;
#pragma unroll
            for (int j = 0; j < 4; ++j) { const f32x4 v = xr[64 * j]; u32x2 w; w.x = cvtpk(v[0], v[1]); w.y = cvtpk(v[2], v[3]); o8[64 * j] = w; }
        }
        for (int e = vcu * 512 + tid; e < 8 * 128 * 64; e += G * 512) CNT[e] = 0u;
        for (int e = vcu * 512 + tid; e < 2 * 1536; e += G * 512) {
            const int c = e % 1536, l = c & 63; const int oc = (c < 1280 && l < 16) ? (c - l + rope_perm32(l)) : c;
            BIASP[e] = ((const float*)args.in[5])[e - c + oc];
        }
        for (int e = vcu * 512 + tid; e < MTOK * 8; e += G * 512) {
            const int m = e >> 3, j = e & 7;
            const float inv = (j == 0) ? 1.0f : (j == 1) ? 0.1939227432012558f : (j == 2) ? 0.03760603070259094f : (j == 3) ? 0.007292664609849453f : (j == 4) ? 0.0014142135623842478f
                            : (j == 5) ? 0.00027424818836152554f : (j == 6) ? 5.3182957344688475e-05f : 1.0313385246263351e-05f;
            const float ang = (float)positions[m] * inv;
            float c, s; sincos_tab(ang, c, s);
            ROPE[(size_t)m * 16 + j] = c; ROPE[(size_t)m * 16 + 8 + j] = s;
        }
        SEAM();
    }
    ++ph;

    for (int layer = 0; layer < DEPTH; ++layer) {
        const int kind = layer % 3, jj = layer / 3;
        const int npass = (kind == 1) ? 3 : 1;
        const int ncol = (kind == 0) ? 1536 : 3072;
        for (int pass = 0; pass < npass; ++pass) {
            if (RUN()) {
                const bf16_t* Wq = (kind == 0) ? Wb + W_AQKV + (size_t)jj * DM * 1536 : (kind == 1) ? Wb + W_BQKV + (size_t)pass * 3072 * DM : Wb + W_CQKV;
                pg8::Gemm g{XN, Wq, MTOK, ncol, DM}; pg8::StaticOrder S; S.init(MTOK, ncol, G, bx);
                pg8::EpiQKV E{QKV, ncol, (kind == 0) ? BIASP + (size_t)jj * 1536 : nullptr, (kind == 0) ? 1280 : 2048, 1024, ROPE};
                pg8::gemm_phase<pg8::EpiQKV, pg8::StaticOrder, true, true>(lds, g, S, E);
                SEAM();
            }
            ++ph;
            if (kind == 2) {
                if (RUN()) {
                    LTID();
                    for (int it = gw; it < BATCH * 16 * 16; it += NGW) {
                        const int b = it >> 8, n = (it >> 4) & 15, h = it & 15;
                        const bf16_t* kp = QKV + ((size_t)b * SEQ + 256 * n + (lane >> 3)) * 3072 + 1024 + h * 64 + (lane & 7) * 8;
                        float s[8];
#pragma unroll
                        for (int j = 0; j < 8; ++j) s[j] = 0.f;
                        for (int i = 0; i < 32; ++i) { const u32x4 v = *(const u32x4*)(kp + (size_t)(8 * i) * 3072);
#pragma unroll
                            for (int j = 0; j < 4; ++j) { s[2 * j] += __uint_as_float(v[j] << 16); s[2 * j + 1] += __uint_as_float(v[j] & 0xffff0000u); } }
#pragma unroll
                        for (int j = 0; j < 8; ++j) { s[j] += shflx(s[j], 8, lane); s[j] += shflx(s[j], 16, lane); s[j] += shflx(s[j], 32, lane); }
                        if (lane < 8) { float* kmp = KMEAN + (size_t)it * 64 + lane * 8;
#pragma unroll
                            for (int j = 0; j < 8; ++j) kmp[j] = s[j] * (1.0f / 256.0f); }
                    }
                    SEAM();
                }
                ++ph;
            }
            if (RUN()) {
                                for (int vc = vcu; vc < 256; vc += G) {
                    if (kind == 0) att::banded_phase<0>(lds, vc, QKV, OB, LSE, (const float*)args.in[6] + jj * 16, 0);
                    else if (kind == 1) att::banded_phase<1>(lds, vc, QKV, OB, LSE, nullptr, pass);
                    else {
                        for (int k = 0; k < 8; ++k) {
                            const int bh = vc >> 1, set = vc & 1, b = bh >> 4, h = bh & 15;
                            const int s_ = set + 2 * (k >> 1), i = (k & 1) ? 15 - s_ : s_;
                            const bf16_t* base = QKV + (size_t)b * SEQ * 3072 + h * 64;
                            att::moba_unit(lds, base, base + 1024, base + 2048, OB + (size_t)b * SEQ * DM + h * 64, 256 * i + 32 * wave, i, KMEAN + ((size_t)b * 256 + h) * 64);
                        }
                    }
                }
                SEAM();
            }
            ++ph;
        }
        for (int sub = 0; sub < 2; ++sub) {
            if (sub == 1) {
                if (RUN()) {
                    pg8::Gemm g{XN, Wb + W_GU + (size_t)layer * DM * 2 * DFF, MTOK, 2 * DFF, DM}; pg8::StaticOrder S; S.init(MTOK, 2 * DFF, G, bx);
                    pg8::EpiSwiGLU E{HB};
                    pg8::gemm_phase<pg8::EpiSwiGLU, pg8::StaticOrder, true, true>(lds, g, S, E);
                    SEAM();
                }
                ++ph;
            }
            if (RUN()) {
                const bf16_t* Wo = (kind == 0) ? Wb + W_AO + (size_t)jj * DM * DM : (kind == 1) ? Wb + W_BO : Wb + W_CO;
                const bf16_t* Wd = Wb + W_DN + (size_t)layer * DM * DFF;
                const float* bias = (sub == 0 && kind == 0) ? (const float*)args.in[8] + (size_t)jj * DM : nullptr;
                const float* xres = (layer == 0 && sub == 0) ? x_in : nullptr;
                float* outp = (layer == DEPTH - 1 && sub == 1) ? out : nullptr;
                const float* gp = ln_g + (size_t)(layer * 2 + sub) * DM; const float* bp = ln_b + (size_t)(layer * 2 + sub) * DM;
                pg8::Gemm g{sub == 0 ? OB : HB, sub == 0 ? Wo : Wd, MTOK, DM, sub == 0 ? DM : DFF};
                {
                    pg8::PanelStats st{XBUF, CNT + (size_t)(layer * 2 + sub) * 128 * 64};
                    pg8::EpiLN E{xres, outp, XN, XLO, bias, gp, bp, st, 1, (outp == nullptr) ? 1 : 0};
                    pg8::StaticOrder S; S.init(MTOK, DM, G, bx);
                    pg8::gemm_phase<pg8::EpiLN, pg8::StaticOrder, true, true>(lds, g, S, E);
                }
                SEAM();
            }
            ++ph;
        }
    }
#undef RUN
#undef SEAM
}

constexpr int NPHASE = 1 + 5 + 9 + 6 + 5;

extern "C" void kernel_launch(void* const* d_in, const int* in_sizes, int n_in, void* d_out, int out_size, void* d_ws, size_t ws_size, hipStream_t stream) {
    static int grid = 0;
    if (grid == 0) {
        if (n_in != 15 || out_size != MTOK * DM || ws_size < WS_END) { fprintf(stderr, "kernel_launch: unexpected shapes (n_in %d out %d ws %zu)\n", n_in, out_size, ws_size); grid = -1; return; }
        int dev = 0, cus = 0, per_cu = 0;
        (void)hipGetDevice(&dev); (void)hipDeviceGetAttribute(&cus, hipDeviceAttributeMultiprocessorCount, dev);
        if (hipFuncSetAttribute((const void*)mega, hipFuncAttributeMaxDynamicSharedMemorySize, LDS_BYTES) != hipSuccess) { fprintf(stderr, "kernel_launch: hipFuncSetAttribute failed\n"); grid = -1; return; }
        if (hipOccupancyMaxActiveBlocksPerMultiprocessor(&per_cu, (const void*)mega, 512, LDS_BYTES) != hipSuccess || per_cu < 1) { fprintf(stderr, "kernel_launch: occupancy query says %d\n", per_cu); per_cu = 1; }
        (void)hipGetLastError();
        grid = cus * per_cu;
        if (grid > 256) grid = 256;
    }
    if (grid < 0) return;
    Args a{};
    for (int i = 0; i < 15; ++i) a.in[i] = d_in[i];
    a.out = (float*)d_out; a.ws = (unsigned char*)d_ws;
#if MK_MULTI
    for (int p = 0; p < NPHASE; ++p) { a.ph_lo = p; a.ph_hi = p + 1; hipLaunchKernelGGL(mega, dim3(grid), dim3(512), LDS_BYTES, stream, a); }
#else
    a.ph_lo = 0; a.ph_hi = NPHASE;
    void* kargs[] = {&a};
    hipError_t e = hipLaunchCooperativeKernel((const void*)mega, dim3(grid), dim3(512), kargs, LDS_BYTES, stream);
    if (e != hipSuccess) fprintf(stderr, "cooperative launch failed: %s (grid %d)\n", hipGetErrorString(e), grid);
#endif
}
```

```cpp
#include <hip/hip_runtime.h>
#include <hip/hip_cooperative_groups.h>
#include <cstdio>
#include <cstdint>
namespace cg = cooperative_groups;

#define LAS __attribute__((address_space(3)))
typedef unsigned short bf16_t;
typedef short bf16x8 __attribute__((ext_vector_type(8)));
typedef float f32x4 __attribute__((ext_vector_type(4)));
typedef float f32x2 __attribute__((ext_vector_type(2)));
typedef float f32x16 __attribute__((ext_vector_type(16)));
typedef unsigned u32x4 __attribute__((ext_vector_type(4)));
typedef unsigned u32x2 __attribute__((ext_vector_type(2)));
typedef short s16x4 __attribute__((ext_vector_type(4)));
typedef __bf16 bf16x2_t __attribute__((ext_vector_type(2)));

#ifndef MK_MULTI
#define MK_MULTI 0
#endif

constexpr int BATCH = 8, SEQ = 4096, DM = 1024, MTOK = BATCH * SEQ, DFF = 2816, HD = 64, DEPTH = 4;
constexpr float DN_ALPHA = 1.6817928305074290861f;
constexpr float LN_EPS = 1e-5f;
constexpr float LOG2E = 1.4426950408889634f;
constexpr float QSCALE = 0.125f * LOG2E;

__device__ __forceinline__ unsigned cvtpk(float lo, float hi) { f32x2 v = {lo, hi}; bf16x2_t b = __builtin_convertvector(v, bf16x2_t); return __builtin_bit_cast(unsigned, b); }
__device__ __forceinline__ float shflx(float v, int mask, int lane) { return __int_as_float(__builtin_amdgcn_ds_bpermute((lane ^ mask) << 2, __float_as_int(v))); }
__device__ __forceinline__ float bf2f(unsigned short b) { return __uint_as_float(((unsigned)b) << 16); }

namespace pg8 {
constexpr int BM = 256, BK = 64, HALF = 128, HTB = HALF * BK * 2, STAGE_BYTES = 8 * HTB, NXCD = 8, WGM = 8;
__host__ __device__ __forceinline__ int lds_byte(int r, int c) { const int st = (r >> 4) * 2 + (c >> 5), rr = r & 15, cc = c & 31, ob = rr * 64 + cc * 2; return st * 1024 + (ob ^ (((ob >> 9) & 1) << 5)); }
__host__ __device__ __forceinline__ void stage_rc(int b, int& R, int& C) { const int st = b / 1024, sb = b % 1024, swz = sb ^ (((sb >> 9) & 1) << 5); R = (st >> 1) * 16 + swz / 64; C = (st & 1) * 32 + (swz % 64) / 2; }
__host__ __device__ __forceinline__ int perm32(int rho) { const int n = rho >> 4, i = rho & 15; return 8 * (i >> 2) + 4 * n + (i & 3); }
struct Unit { int pm, pn; };
struct Gemm { const bf16_t* A; const bf16_t* Bt; int M, N, K; };
struct StaticOrder {
    int nM, nN, nwg, G, c;
    __host__ __device__ void init(int M, int N, int G_, int c_) { nM = M / BM; nN = N / BM; nwg = nM * nN; G = G_; c = c_; }
    __host__ __device__ bool next(int i, Unit& u) const {
        const long L = (long)i * G + c; if (L >= nwg) return false;
        int wgid = (int)L; { const int q = nwg / NXCD, r = nwg % NXCD, xcd = wgid % NXCD, off = wgid / NXCD; wgid = (xcd < r ? xcd * (q + 1) : r * (q + 1) + (xcd - r) * q) + off; }
        const int nig = WGM * nN, gid = wgid / nig, fm = gid * WGM, gsz = (nM - fm) < WGM ? (nM - fm) : WGM;
        u.pm = fm + ((wgid % nig) % gsz); u.pn = (wgid % nig) / gsz; return true;
    }
};

struct EpiQKV {
    static constexpr bool PERM = true, AFTER_DRAIN = false, FUSED_MID = false;
    bf16_t* O; int ldc; const float* bias; int rope_cols, q_cols; const float* rope;
    __device__ __forceinline__ void operator()(const f32x4 (&acc)[2][2][4][2], const Unit& u, int wr, int wc, int fr, int fq) const {
        const int row0 = u.pm * BM + wr * 64 + fr, colt = u.pn * BM, col0 = colt + wc * 32 + 8 * fq;
        const bool do_rope = (colt < rope_cols) && ((wc & 1) == 0);
        const float sc = (colt < q_cols) ? QSCALE : 1.0f;
        f32x4 bv[2][2];
#pragma unroll
        for (int bj = 0; bj < 2; ++bj)
#pragma unroll
            for (int n = 0; n < 2; ++n) bv[bj][n] = bias ? *(const f32x4*)(bias + col0 + bj * HALF + 4 * n) : (f32x4){0.f, 0.f, 0.f, 0.f};
        f32x4 csa[2][4], sna[2][4];
        if (do_rope) {
#pragma unroll
            for (int e = 0; e < 6; ++e) { const int ai = e >> 2, m = e & 3; const float* rp = rope + (size_t)(row0 + ai * HALF + m * 16) * 16 + 4 * (fq & 1); csa[ai][m] = *(const f32x4*)rp; sna[ai][m] = *(const f32x4*)(rp + 8); }
        }
#pragma unroll
        for (int ai = 0; ai < 2; ++ai) {
            if (ai == 1) {
                asm volatile("" ::: "memory");
                if (do_rope) {
#pragma unroll
                    for (int m = 2; m < 4; ++m) { const float* rp = rope + (size_t)(row0 + HALF + m * 16) * 16 + 4 * (fq & 1); csa[1][m] = *(const f32x4*)rp; sna[1][m] = *(const f32x4*)(rp + 8); }
                }
            }
#pragma unroll
            for (int m = 0; m < 4; ++m) {
                bf16_t* rowp = O + (size_t)(row0 + ai * HALF + m * 16) * ldc + col0;
#pragma unroll
                for (int bj = 0; bj < 2; ++bj) {
                    f32x4 v0 = acc[ai][bj][m][0] + bv[bj][0], v1 = acc[ai][bj][m][1] + bv[bj][1];
                    if (do_rope && fq < 2) {
                        const f32x4 c = csa[ai][m], s_ = sna[ai][m];
                        const f32x4 r0 = {v0[0] * c[0] - v0[1] * s_[0], v0[1] * c[0] + v0[0] * s_[0], v0[2] * c[1] - v0[3] * s_[1], v0[3] * c[1] + v0[2] * s_[1]};
                        const f32x4 r1 = {v1[0] * c[2] - v1[1] * s_[2], v1[1] * c[2] + v1[0] * s_[2], v1[2] * c[3] - v1[3] * s_[3], v1[3] * c[3] + v1[2] * s_[3]};
                        v0 = r0; v1 = r1;
                    }
                    v0 = v0 * sc; v1 = v1 * sc;
                    u32x4 w; w.x = cvtpk(v0[0], v0[1]); w.y = cvtpk(v0[2], v0[3]); w.z = cvtpk(v1[0], v1[1]); w.w = cvtpk(v1[2], v1[3]);
                    *(u32x4*)(rowp + bj * HALF) = w;
                }
            }
        }
    }
};
struct EpiResid {
    static constexpr bool PERM = false, AFTER_DRAIN = false, FUSED_MID = false;
    const float* xres; float* out; const float* bias;
    __device__ __forceinline__ void operator()(const f32x4 (&acc)[2][2][4][2], const Unit& u, int wr, int wc, int fr, int fq) const {
        const int col0 = u.pn * BM + wc * 32 + 4 * fq;
        f32x4 bv[2][2];
#pragma unroll
        for (int bj = 0; bj < 2; ++bj)
#pragma unroll
            for (int n = 0; n < 2; ++n) bv[bj][n] = bias ? *(const f32x4*)(bias + col0 + bj * HALF + n * 16) : (f32x4){0.f, 0.f, 0.f, 0.f};
#pragma unroll
        for (int ai = 0; ai < 2; ++ai)
#pragma unroll
            for (int m = 0; m < 4; ++m) {
                const size_t off = (size_t)(u.pm * BM + ai * HALF + wr * 64 + m * 16 + fr) * DM + col0;
#pragma unroll
                for (int bj = 0; bj < 2; ++bj)
#pragma unroll
                    for (int n = 0; n < 2; ++n) { const f32x4 bs = *(const f32x4*)(xres + off + bj * HALF + n * 16); *(f32x4*)(out + off + bj * HALF + n * 16) = bs * DN_ALPHA + (acc[ai][bj][m][n] + bv[bj][n]); }
            }
    }
};
struct EpiSwiGLU {
    static constexpr bool PERM = true, AFTER_DRAIN = false, FUSED_MID = false;
    bf16_t* H;
    __device__ __forceinline__ void operator()(const f32x4 (&acc)[2][2][4][2], const Unit& u, int wr, int wc, int fr, int fq) const {
        const int col0 = u.pn * HALF + wc * 32 + 8 * fq;
#pragma unroll
        for (int ai = 0; ai < 2; ++ai)
#pragma unroll
            for (int m = 0; m < 4; ++m) {
                bf16_t* rowp = H + (size_t)(u.pm * BM + ai * HALF + wr * 64 + m * 16 + fr) * DFF + col0;
                float h[8];
#pragma unroll
                for (int n = 0; n < 2; ++n)
#pragma unroll
                    for (int i = 0; i < 4; ++i) { const float g = acc[ai][0][m][n][i], up = acc[ai][1][m][n][i]; h[n * 4 + i] = g * __builtin_amdgcn_rcpf(1.0f + __builtin_amdgcn_exp2f(-g * LOG2E)) * up; }
                u32x4 w; w.x = cvtpk(h[0], h[1]); w.y = cvtpk(h[2], h[3]); w.z = cvtpk(h[4], h[5]); w.w = cvtpk(h[6], h[7]);
                *(u32x4*)rowp = w;
            }
    }
};

struct PanelStats {
    unsigned long long* xbuf;
    unsigned* cnt;
    __device__ __forceinline__ void run(const f32x4 (&v)[2][2][4][2], const Unit& u, int wr, int wc, int fr, int fq, LAS unsigned char* lds, int wid, int lane) const {
        LAS f32x2* P = (LAS f32x2*)(lds + STAGE_BYTES);
        LAS f32x2* S = (LAS f32x2*)(lds + STAGE_BYTES + 8192);
#pragma unroll
        for (int ai = 0; ai < 2; ++ai)
#pragma unroll
            for (int m = 0; m < 4; ++m) {
                float s = 0.f;
#pragma unroll
                for (int bj = 0; bj < 2; ++bj)
#pragma unroll
                    for (int n = 0; n < 2; ++n) { const f32x4 x = v[ai][bj][m][n]; s += (x[0] + x[1]) + (x[2] + x[3]); }
                s += shflx(s, 16, lane); s += shflx(s, 32, lane);
                const float mw = s * (1.0f / 64.0f); float q = 0.f;
#pragma unroll
                for (int bj = 0; bj < 2; ++bj)
#pragma unroll
                    for (int n = 0; n < 2; ++n) { const f32x4 d = v[ai][bj][m][n] - mw; q += (d[0] * d[0] + d[1] * d[1]) + (d[2] * d[2] + d[3] * d[3]); }
                q += shflx(q, 16, lane); q += shflx(q, 32, lane);
                if (fq == 0) P[(ai * HALF + wr * 64 + m * 16 + fr) * 4 + wc] = (f32x2){mw, q};
            }
        asm volatile("s_waitcnt lgkmcnt(0)" ::: "memory"); __builtin_amdgcn_s_barrier(); asm volatile("" ::: "memory");
        const int row = wid * 32 + (lane & 31);
        if (lane < 32) {
            const f32x2 a = P[row * 4 + 0], b = P[row * 4 + 1], c = P[row * 4 + 2], d = P[row * 4 + 3];
            const float mt = (a.x + b.x + c.x + d.x) * 0.25f;
            const float da = a.x - mt, db = b.x - mt, dc = c.x - mt, dd = d.x - mt;
            const float m2 = (a.y + b.y) + (c.y + d.y) + 64.0f * ((da * da + db * db) + (dc * dc + dd * dd));
            unsigned long long* slot = xbuf + ((size_t)(u.pm * BM + row) * 4 + u.pn);
            __hip_atomic_store(slot, ((unsigned long long)__float_as_uint(m2) << 32) | __float_as_uint(mt), __ATOMIC_RELAXED, __HIP_MEMORY_SCOPE_AGENT);
        }
        asm volatile("s_waitcnt vmcnt(0)" ::: "memory");
        if (lane == 0) __hip_atomic_fetch_add(cnt + 64 * u.pm, 1u, __ATOMIC_RELAXED, __HIP_MEMORY_SCOPE_AGENT);
        if (wid == 0) {
            unsigned sp = 0u;
            for (;;) {
                if ((unsigned)__builtin_amdgcn_readfirstlane(__hip_atomic_load(cnt + 64 * u.pm, __ATOMIC_RELAXED, __HIP_MEMORY_SCOPE_AGENT)) >= 32u) break;
                if (++sp > (1u << 24)) break;
                __builtin_amdgcn_s_sleep(2);
            }
            __builtin_amdgcn_fence(__ATOMIC_ACQUIRE, "agent");
        }
        asm volatile("s_waitcnt vmcnt(0) lgkmcnt(0)" ::: "memory"); __builtin_amdgcn_s_barrier(); asm volatile("" ::: "memory");
        if (lane < 32) {
            const unsigned long long* slot = xbuf + (size_t)(u.pm * BM + row) * 4; float mt[4], m2[4]; float ms = 0.f;
#pragma unroll
            for (int t = 0; t < 4; ++t) { const unsigned long long w = __hip_atomic_load(slot + t, __ATOMIC_RELAXED, __HIP_MEMORY_SCOPE_AGENT); mt[t] = __uint_as_float((unsigned)w); m2[t] = __uint_as_float((unsigned)(w >> 32)); ms += mt[t]; }
            const float mean = ms * 0.25f; float q = 0.f;
#pragma unroll
            for (int t = 0; t < 4; ++t) { const float dm = mt[t] - mean; q += m2[t] + 256.0f * dm * dm; }
            S[row] = (f32x2){mean, 1.0f / sqrtf(q * (1.0f / 1024.0f) + LN_EPS)};
        }
        asm volatile("s_waitcnt lgkmcnt(0)" ::: "memory"); __builtin_amdgcn_s_barrier(); asm volatile("" ::: "memory");
    }
};
struct EpiLN {
    static constexpr bool PERM = true, AFTER_DRAIN = false, FUSED_MID = true;
    const float* xres; float* out; bf16_t* xn; bf16_t* xlo; const float* bias; const float* gamma; const float* beta; PanelStats st; int rd_lo, wr_lo;
    __device__ __forceinline__ void fused(f32x4 (&acc)[2][2][4][2], const Unit& u, int wr, int wc, int fr, int fq, LAS unsigned char* lds, int wid, int lane) const {
        const LAS f32x2* S = (const LAS f32x2*)(lds + STAGE_BYTES + 8192);
        const int col0 = u.pn * BM + wc * 32 + 8 * fq;
#pragma unroll
        for (int bj = 0; bj < 2; ++bj)
#pragma unroll
            for (int n = 0; n < 2; ++n) { const f32x4 bv = bias ? *(const f32x4*)(bias + col0 + bj * HALF + 4 * n) : (f32x4){0.f, 0.f, 0.f, 0.f};
#pragma unroll
                for (int ai = 0; ai < 2; ++ai)
#pragma unroll
                    for (int m = 0; m < 4; ++m) acc[ai][bj][m][n] += bv; }
#pragma unroll
        for (int ab = 0; ab < 4; ++ab) {
            const int ai = ab >> 1, m0 = (ab & 1) * 2;
            f32x4 xr[2][2][2];
            if (xres) {
#pragma unroll
                for (int mm = 0; mm < 2; ++mm) { const size_t off = (size_t)(u.pm * BM + ai * HALF + wr * 64 + (m0 + mm) * 16 + fr) * DM + col0;
#pragma unroll
                    for (int bj = 0; bj < 2; ++bj)
#pragma unroll
                        for (int n = 0; n < 2; ++n) xr[mm][bj][n] = *(const f32x4*)(xres + off + bj * HALF + 4 * n); }
            } else {
                u32x4 xh[2][2], xl8[2];
#pragma unroll
                for (int mm = 0; mm < 2; ++mm) { const size_t off = (size_t)(u.pm * BM + ai * HALF + wr * 64 + (m0 + mm) * 16 + fr) * DM + col0;
#pragma unroll
                    for (int bj = 0; bj < 2; ++bj) xh[mm][bj] = *(const u32x4*)(xn + off + bj * HALF);
                    xl8[mm] = rd_lo ? *(const u32x4*)(xlo + (((size_t)(u.pm * 4 + u.pn) * 8 + ai * 4 + (m0 + mm)) * 512 + (wid * 64 + lane)) * 8) : (u32x4){0u, 0u, 0u, 0u}; }
#pragma unroll
                for (int mm = 0; mm < 2; ++mm)
#pragma unroll
                    for (int bj = 0; bj < 2; ++bj)
#pragma unroll
                        for (int n = 0; n < 2; ++n)
#pragma unroll
                            for (int i = 0; i < 2; ++i) { const unsigned h = xh[mm][bj][2 * n + i];
                                const f32x2 lr = i ? __builtin_amdgcn_cvt_pk_f32_bf8((int)xl8[mm][bj * 2 + n], true) : __builtin_amdgcn_cvt_pk_f32_bf8((int)xl8[mm][bj * 2 + n], false);
                                xr[mm][bj][n][2 * i] = __uint_as_float(h << 16) + lr[0] * (1.0f / 4096.0f); xr[mm][bj][n][2 * i + 1] = __uint_as_float(h & 0xffff0000u) + lr[1] * (1.0f / 4096.0f); }
            }
#pragma unroll
            for (int mm = 0; mm < 2; ++mm) { const int m = m0 + mm;
#pragma unroll
                for (int bj = 0; bj < 2; ++bj)
#pragma unroll
                    for (int n = 0; n < 2; ++n) acc[ai][bj][m][n] += xr[mm][bj][n] * DN_ALPHA;
                asm volatile("" : "+v"(acc[ai][0][m][0]), "+v"(acc[ai][0][m][1]), "+v"(acc[ai][1][m][0]), "+v"(acc[ai][1][m][1])); }
            asm volatile("" ::: "memory");
        }
        st.run(acc, u, wr, wc, fr, fq, lds, wid, lane);
        f32x4 gv[2][2], bt[2][2];
#pragma unroll
        for (int bj = 0; bj < 2; ++bj)
#pragma unroll
            for (int n = 0; n < 2; ++n) { gv[bj][n] = *(const f32x4*)(gamma + col0 + bj * HALF + 4 * n); bt[bj][n] = *(const f32x4*)(beta + col0 + bj * HALF + 4 * n); }
#pragma unroll
        for (int ai = 0; ai < 2; ++ai)
#pragma unroll
            for (int m = 0; m < 4; ++m) { const int r = ai * HALF + wr * 64 + m * 16 + fr; const f32x2 sr = S[r]; const size_t off = (size_t)(u.pm * BM + r) * DM + col0; u32x4 wl8;
#pragma unroll
                for (int bj = 0; bj < 2; ++bj) {
                    const f32x4 y0 = (acc[ai][bj][m][0] - sr.x) * sr.y * gv[bj][0] + bt[bj][0], y1 = (acc[ai][bj][m][1] - sr.x) * sr.y * gv[bj][1] + bt[bj][1];
                    if (out) { *(f32x4*)(out + off + bj * HALF) = y0; *(f32x4*)(out + off + bj * HALF + 4) = y1; }
                    u32x4 w; w.x = cvtpk(y0[0], y0[1]); w.y = cvtpk(y0[2], y0[3]); w.z = cvtpk(y1[0], y1[1]); w.w = cvtpk(y1[2], y1[3]);
                    if (!out) *(u32x4*)(xn + off + bj * HALF) = w;
                    { int d0 = __builtin_amdgcn_cvt_pk_bf8_f32((y0[0] - __uint_as_float(w.x << 16)) * 4096.0f, (y0[1] - __uint_as_float(w.x & 0xffff0000u)) * 4096.0f, 0, false);
                      d0 = __builtin_amdgcn_cvt_pk_bf8_f32((y0[2] - __uint_as_float(w.y << 16)) * 4096.0f, (y0[3] - __uint_as_float(w.y & 0xffff0000u)) * 4096.0f, d0, true);
                      int d1 = __builtin_amdgcn_cvt_pk_bf8_f32((y1[0] - __uint_as_float(w.z << 16)) * 4096.0f, (y1[1] - __uint_as_float(w.z & 0xffff0000u)) * 4096.0f, 0, false);
                      d1 = __builtin_amdgcn_cvt_pk_bf8_f32((y1[2] - __uint_as_float(w.w << 16)) * 4096.0f, (y1[3] - __uint_as_float(w.w & 0xffff0000u)) * 4096.0f, d1, true);
                      wl8[bj * 2] = (unsigned)d0; wl8[bj * 2 + 1] = (unsigned)d1; }
                    }
                if (wr_lo) *(u32x4*)(xlo + (((size_t)(u.pm * 4 + u.pn) * 8 + ai * 4 + m) * 512 + (wid * 64 + lane)) * 8) = wl8; }
        asm volatile("s_waitcnt lgkmcnt(0)" ::: "memory"); __builtin_amdgcn_s_barrier(); asm volatile("" ::: "memory");
    }
};
struct OneRound {
    StaticOrder S; int round;
    __device__ bool next(int i, Unit& u) const { return (i == 0) && S.next(round, u); }
};

template <class Epi, class Sched, bool ALIGN_EPI = false, bool SP2 = false>
__device__ __forceinline__ void gemm_phase(LAS unsigned char* lds, const Gemm g, const Sched& S, const Epi& E) {
    int tid_ = threadIdx.x; asm volatile("" : "+v"(tid_));
    const int tid = tid_, wid = __builtin_amdgcn_readfirstlane(tid >> 6), lane = tid & 63, wr = wid >> 2, wc = wid & 3, fr = lane & 15, fq = lane >> 4;
    const bf16_t* gA_ = g.A; const bf16_t* gB_ = g.Bt; asm volatile("" : "+s"(gA_), "+s"(gB_));
    const int K = g.K, nt = K / BK;
    unsigned voffA[2], voffB[2];
#pragma unroll
    for (int i = 0; i < 2; ++i) { int R, C; stage_rc(tid * 16 + i * 8192, R, C); const int Rb = Epi::PERM ? ((R & ~31) + perm32(R & 31)) : R;
        voffA[i] = (unsigned)(R * K + C) * 2u; voffB[i] = (unsigned)(Rb * K + C) * 2u; }
    const size_t kstep = (size_t)(BK * 2);
    const size_t hstep = (size_t)HALF * K * 2;
    const size_t tstep = 2 * hstep;
    const unsigned ldsw = (unsigned)wid * 1024u;
    const int aoff = lds_byte(wr * 64 + fr, fq * 8), boff = lds_byte(wc * 32 + fr, fq * 8);
#define PG8_SA(b, h) (((b) * 2 + (h)) * HTB)
#define PG8_SB(b, h) ((4 + (b) * 2 + (h)) * HTB)
#define PG8_STAGE(bufoff, gbase, voff) do { _Pragma("unroll") for (int _i = 0; _i < 2; ++_i) \
        __builtin_amdgcn_global_load_lds((const unsigned*)((const char*)(gbase) + (voff)[_i]), (LAS unsigned*)(lds + (bufoff) + ldsw + _i * 8192), 16, 0, 0); } while (0)
#define PG8_LDA(dst, b, h) do { _Pragma("unroll") for (int m = 0; m < 4; ++m) _Pragma("unroll") for (int k = 0; k < 2; ++k) dst[m][k] = *(const LAS bf16x8*)(lds + PG8_SA(b, h) + aoff + m * 2048 + k * 1024); } while (0)
#define PG8_LDB(dst, b, h) do { _Pragma("unroll") for (int n = 0; n < 2; ++n) _Pragma("unroll") for (int k = 0; k < 2; ++k) dst[n][k] = *(const LAS bf16x8*)(lds + PG8_SB(b, h) + boff + n * 2048 + k * 1024); } while (0)
#define PG8_MMA(ai, bj, At, Bt) do { __builtin_amdgcn_s_setprio(1); _Pragma("unroll") for (int m = 0; m < 4; ++m) _Pragma("unroll") for (int n = 0; n < 2; ++n) _Pragma("unroll") for (int k = 0; k < 2; ++k) \
        acc[ai][bj][m][n] = __builtin_amdgcn_mfma_f32_16x16x32_bf16(Bt[n][k], At[m][k], acc[ai][bj][m][n], 0, 0, 0); __builtin_amdgcn_s_setprio(0); } while (0)
#define PG8_WAIT_V(n) asm volatile("s_waitcnt vmcnt(" #n ")" ::: "memory")
#define PG8_WAIT_L(n) asm volatile("s_waitcnt lgkmcnt(" #n ")" ::: "memory")
#define PG8_BAR __builtin_amdgcn_s_barrier()
#define PG8_SCHED __builtin_amdgcn_sched_barrier(0)
    Unit cur, nxt; int ui = 0;
    if (!S.next(0, cur)) return;
    f32x4 acc[2][2][4][2];
#pragma unroll
    for (int a = 0; a < 2; ++a)
#pragma unroll
        for (int b = 0; b < 2; ++b)
#pragma unroll
            for (int m = 0; m < 4; ++m)
#pragma unroll
                for (int n = 0; n < 2; ++n) acc[a][b][m][n] = (f32x4){0.f, 0.f, 0.f, 0.f};
    bf16x8 At[4][2], B0[2][2], B1[2][2];
    const char* cA = (const char*)gA_ + (size_t)cur.pm * tstep; const char* cB = (const char*)gB_ + (size_t)cur.pn * tstep;
    if constexpr (SP2) {
        PG8_STAGE(PG8_SB(0, 0), cB, voffB); PG8_STAGE(PG8_SB(0, 1), cB + hstep, voffB); PG8_STAGE(PG8_SA(0, 0), cA, voffA); PG8_STAGE(PG8_SA(0, 1), cA + hstep, voffA);
        if (wr == 1) PG8_BAR;
        PG8_WAIT_V(2); PG8_BAR;
        PG8_STAGE(PG8_SB(1, 0), cB + kstep, voffB); PG8_STAGE(PG8_SA(1, 0), cA + kstep, voffA); PG8_STAGE(PG8_SB(1, 1), cB + hstep + kstep, voffB);
        PG8_WAIT_V(6); PG8_BAR;
    } else {
        PG8_STAGE(PG8_SB(0, 0), cB, voffB); PG8_STAGE(PG8_SA(0, 0), cA, voffA); PG8_STAGE(PG8_SB(0, 1), cB + hstep, voffB); PG8_STAGE(PG8_SA(0, 1), cA + hstep, voffA);
        if (wr == 1) PG8_BAR;
        PG8_WAIT_V(4); PG8_BAR;
        PG8_STAGE(PG8_SB(1, 0), cB + kstep, voffB); PG8_STAGE(PG8_SA(1, 0), cA + kstep, voffA); PG8_STAGE(PG8_SB(1, 1), cB + hstep + kstep, voffB);
        PG8_WAIT_V(6); PG8_BAR;
    }
    for (;;) {
        const bool has_next = S.next(ui + 1, nxt);
        const char* nA = has_next ? (const char*)gA_ + (size_t)nxt.pm * tstep : cA; const char* nB = has_next ? (const char*)gB_ + (size_t)nxt.pn * tstep : cB;
        for (int t = 0; t < nt; t += 2) {
            const bool last = (t == nt - 2);
            const char* a1 = cA + (size_t)(t + 1) * kstep;
            const char* a2 = last ? nA : cA + (size_t)(t + 2) * kstep; const char* b2 = last ? nB : cB + (size_t)(t + 2) * kstep;
            const char* a3 = a2 + kstep; const char* b3 = b2 + kstep;
            if constexpr (SP2) {
            PG8_LDB(B0, 0, 0); PG8_LDB(B1, 0, 1); PG8_SCHED; PG8_LDA(At, 0, 0); PG8_STAGE(PG8_SA(1, 1), a1 + hstep, voffA);
            PG8_WAIT_V(8); PG8_WAIT_L(0); PG8_BAR; PG8_MMA(0, 0, At, B0); PG8_MMA(0, 1, At, B1); PG8_BAR; PG8_SCHED;
            PG8_LDA(At, 0, 1); PG8_STAGE(PG8_SB(0, 0), b2, voffB); PG8_STAGE(PG8_SB(0, 1), b2 + hstep, voffB); PG8_STAGE(PG8_SA(0, 0), a2, voffA);
            PG8_WAIT_V(8); PG8_WAIT_L(0); PG8_BAR; PG8_MMA(1, 0, At, B0); PG8_MMA(1, 1, At, B1); PG8_BAR; PG8_SCHED;
            PG8_LDB(B0, 1, 0); PG8_LDB(B1, 1, 1); PG8_SCHED; PG8_LDA(At, 1, 0); PG8_STAGE(PG8_SA(0, 1), a2 + hstep, voffA);
            PG8_WAIT_V(8); PG8_WAIT_L(0); PG8_BAR; PG8_MMA(0, 0, At, B0); PG8_MMA(0, 1, At, B1); PG8_BAR; PG8_SCHED;
            PG8_LDA(At, 1, 1); PG8_STAGE(PG8_SB(1, 0), b3, voffB); PG8_STAGE(PG8_SB(1, 1), b3 + hstep, voffB); PG8_STAGE(PG8_SA(1, 0), a3, voffA);
            PG8_WAIT_V(8); PG8_WAIT_L(0); PG8_BAR; PG8_MMA(1, 0, At, B0); PG8_MMA(1, 1, At, B1); PG8_BAR; PG8_SCHED;
            } else {
            PG8_LDB(B0, 0, 0); PG8_SCHED; PG8_LDA(At, 0, 0); PG8_STAGE(PG8_SA(1, 1), a1 + hstep, voffA);
            PG8_WAIT_L(8); PG8_BAR; PG8_WAIT_L(0); PG8_MMA(0, 0, At, B0); PG8_BAR; PG8_SCHED;
            PG8_LDB(B1, 0, 1); PG8_STAGE(PG8_SB(0, 0), b2, voffB);
            PG8_BAR; PG8_WAIT_L(0); PG8_MMA(0, 1, At, B1); PG8_BAR;
            PG8_LDA(At, 0, 1); PG8_STAGE(PG8_SA(0, 0), a2, voffA);
            PG8_BAR; PG8_WAIT_L(0); PG8_MMA(1, 0, At, B0); PG8_BAR; PG8_SCHED;
            PG8_STAGE(PG8_SB(0, 1), b2 + hstep, voffB);
            PG8_WAIT_V(6); PG8_BAR; PG8_MMA(1, 1, At, B1); PG8_BAR;
            PG8_LDB(B0, 1, 0); PG8_SCHED; PG8_LDA(At, 1, 0); PG8_STAGE(PG8_SA(0, 1), a2 + hstep, voffA);
            PG8_WAIT_L(8); PG8_BAR; PG8_WAIT_L(0); PG8_MMA(0, 0, At, B0); PG8_BAR; PG8_SCHED;
            PG8_LDB(B1, 1, 1); PG8_STAGE(PG8_SB(1, 0), b3, voffB);
            PG8_BAR; PG8_WAIT_L(0); PG8_MMA(0, 1, At, B1); PG8_BAR;
            PG8_LDA(At, 1, 1); PG8_STAGE(PG8_SA(1, 0), a3, voffA);
            PG8_BAR; PG8_WAIT_L(0); PG8_MMA(1, 0, At, B0); PG8_BAR; PG8_SCHED;
            PG8_STAGE(PG8_SB(1, 1), b3 + hstep, voffB);
            PG8_WAIT_V(6); PG8_BAR; PG8_MMA(1, 1, At, B1); PG8_BAR;
            }
        }
        if constexpr (ALIGN_EPI) { if (wr == 0) PG8_BAR; }
        if constexpr (!Epi::AFTER_DRAIN) { if constexpr (Epi::FUSED_MID) E.fused(acc, cur, wr, wc, fr, fq, lds, wid, lane); else E(acc, cur, wr, wc, fr, fq); }
        if (!has_next) break;
#pragma unroll
        for (int a = 0; a < 2; ++a)
#pragma unroll
            for (int b = 0; b < 2; ++b)
#pragma unroll
                for (int m = 0; m < 4; ++m)
#pragma unroll
                    for (int n = 0; n < 2; ++n) acc[a][b][m][n] = (f32x4){0.f, 0.f, 0.f, 0.f};
        cur = nxt; cA = nA; cB = nB; ++ui;
        if constexpr (ALIGN_EPI) { if (wr == 1) PG8_BAR; }
    }
    PG8_WAIT_V(0);
    if constexpr (!ALIGN_EPI) { if (wr == 0) PG8_BAR; }
    PG8_BAR;
    if constexpr (Epi::AFTER_DRAIN) E.fused(acc, cur, wr, wc, fr, fq, lds, wid, lane);
#undef PG8_SA
#undef PG8_SB
#undef PG8_STAGE
#undef PG8_LDA
#undef PG8_LDB
#undef PG8_MMA
#undef PG8_WAIT_V
#undef PG8_WAIT_L
#undef PG8_BAR
#undef PG8_SCHED
}
}

namespace att {
constexpr int KCH = 1040, KSLOT = 8 * KCH  , KOFF = 0, VOFF_S = 16384, VOFF_B = 6 * KSLOT  , WSF = VOFF_B + 6 * 8192, OST = WSF + 4096, KM = OST + 32768, ATT_LDS = KM + 4096;
__device__ __forceinline__ int crow(int r, int hi) { return (r & 3) + 8 * (r >> 2) + 4 * hi; }
__device__ __forceinline__ float xhalf_max(float m) { auto rr = __builtin_amdgcn_permlane32_swap(__float_as_uint(m), __float_as_uint(m), false, false); return fmaxf(__uint_as_float(rr[0]), __uint_as_float(rr[1])); }
__device__ __forceinline__ float xhalf_sum(float m) { auto rr = __builtin_amdgcn_permlane32_swap(__float_as_uint(m), __float_as_uint(m), false, false); return __uint_as_float(rr[0]) + __uint_as_float(rr[1]); }
__device__ __forceinline__ s16x4 vtr(const LAS unsigned char* p) { return __builtin_bit_cast(s16x4, __builtin_amdgcn_ds_read_tr16_b64_v4i16((LAS s16x4*)p)); }
struct State { float mref, lsum; f32x16 o0, o1; };

__device__ __forceinline__ void tile_s(const LAS unsigned char* kb, const bf16x8 (&qr)[4], f32x16& p0, f32x16& p1) {
    {
        const f32x16 z = {0.f, 0.f, 0.f, 0.f, 0.f, 0.f, 0.f, 0.f, 0.f, 0.f, 0.f, 0.f, 0.f, 0.f, 0.f, 0.f};
        const bf16x8 a0 = *(const LAS bf16x8*)(kb), a1 = *(const LAS bf16x8*)(kb + 512);
        p0 = __builtin_amdgcn_mfma_f32_32x32x16_bf16(a0, qr[0], z, 0, 0, 0);
        p1 = __builtin_amdgcn_mfma_f32_32x32x16_bf16(a1, qr[0], z, 0, 0, 0);
    }
#pragma unroll
    for (int d0 = 1; d0 < 4; ++d0) {
        const bf16x8 a0 = *(const LAS bf16x8*)(kb + d0 * 2 * KCH), a1 = *(const LAS bf16x8*)(kb + d0 * 2 * KCH + 512);
        p0 = __builtin_amdgcn_mfma_f32_32x32x16_bf16(a0, qr[d0], p0, 0, 0, 0);
        p1 = __builtin_amdgcn_mfma_f32_32x32x16_bf16(a1, qr[d0], p1, 0, 0, 0);
    }
}
template <int MODE>
__device__ __forceinline__ void tile_finish(f32x16& p0, f32x16& p1, const LAS unsigned char* vp, State& st, LAS float* wsf, int r32, int hi, int k0, int qi, bool full, bool past, bool bit) {
    constexpr int NB = (MODE == 0) ? 127 : 128;
    if (__any(st.mref != 0.f)) {
#pragma unroll
        for (int r = 0; r < 16; ++r) { p0[r] -= st.mref; p1[r] -= st.mref; }
    }
    if (!full) {
        if (MODE == 2 && past) {
        } else {
#pragma unroll
            for (int r = 0; r < 16; ++r) {
                const int kk = k0 + crow(r, hi);
                bool ok0 = (kk <= qi), ok1 = (kk + 32 <= qi);
                if (MODE != 2) { ok0 = ok0 && (kk >= qi - NB); ok1 = ok1 && (kk + 32 >= qi - NB); }
                if (!ok0) p0[r] = -INFINITY;
                if (!ok1) p1[r] = -INFINITY;
            }
        }
    }
    float rm = fmaxf(p0[0], p1[0]);
#pragma unroll
    for (int r = 1; r < 16; ++r) rm = __builtin_fmaxf(__builtin_fmaxf(rm, p0[r]), p1[r]);
    rm = xhalf_max(rm);
    if (__any(rm > 8.0f)) {
        const float dl = fmaxf(rm, 0.f);
        st.mref += dl;
#pragma unroll
        for (int r = 0; r < 16; ++r) { p0[r] -= dl; p1[r] -= dl; }
        const float f = __builtin_amdgcn_exp2f(-dl);
        st.lsum *= f;
        if (hi == 0) wsf[r32] = f;
        asm volatile("s_waitcnt lgkmcnt(0)" ::: "memory");
#pragma unroll
        for (int r = 0; r < 16; ++r) { const float fr_ = wsf[crow(r, hi)]; st.o0[r] *= fr_; st.o1[r] *= fr_; }
        asm volatile("s_waitcnt lgkmcnt(0)" ::: "memory");
    }
#pragma unroll
    for (int r = 0; r < 16; ++r) { p0[r] = __builtin_amdgcn_exp2f(p0[r]); p1[r] = __builtin_amdgcn_exp2f(p1[r]); }
    float ps;
    { const f32x16 sv = p0 + p1; const f32x4 s4 = (f32x4){sv[0], sv[1], sv[2], sv[3]} + (f32x4){sv[4], sv[5], sv[6], sv[7]} + (f32x4){sv[8], sv[9], sv[10], sv[11]} + (f32x4){sv[12], sv[13], sv[14], sv[15]};
      ps = (s4[0] + s4[1]) + (s4[2] + s4[3]); }
    u32x4 pw[4];
#pragma unroll
    for (int j = 0; j < 4; ++j) { pw[0][j] = cvtpk(p0[2 * j], p0[2 * j + 1]); pw[1][j] = cvtpk(p0[8 + 2 * j], p0[9 + 2 * j]); pw[2][j] = cvtpk(p1[2 * j], p1[2 * j + 1]); pw[3][j] = cvtpk(p1[8 + 2 * j], p1[9 + 2 * j]); }
    if (MODE == 2 && past && !full) {
        const unsigned km = bit ? 0xffffffffu : 0u;
#pragma unroll
        for (int k = 0; k < 4; ++k) { pw[k][0] &= km; pw[k][1] &= km; pw[k][2] &= km; pw[k][3] &= km; }
        ps = bit ? ps : 0.f;
    }
    st.lsum += ps;
#pragma unroll
    for (int ks = 0; ks < 4; ++ks) {
        const bf16x8 pa = __builtin_bit_cast(bf16x8, pw[ks]);
        { const s16x4 lo = vtr(vp + ks * 1024), hh = vtr(vp + ks * 1024 + 512);
          const bf16x8 vb = {lo[0], lo[1], lo[2], lo[3], hh[0], hh[1], hh[2], hh[3]};
          st.o0 = __builtin_amdgcn_mfma_f32_32x32x16_bf16(pa, vb, st.o0, 0, 0, 0); }
        { const s16x4 lo = vtr(vp + 4096 + ks * 1024), hh = vtr(vp + 4096 + ks * 1024 + 512);
          const bf16x8 vb = {lo[0], lo[1], lo[2], lo[3], hh[0], hh[1], hh[2], hh[3]};
          st.o1 = __builtin_amdgcn_mfma_f32_32x32x16_bf16(pa, vb, st.o1, 0, 0, 0); }
    }
}
template <int MODE, bool PIPE>
__device__ __forceinline__ void run_range(LAS unsigned char* lds, int ta, int tb, int slot_base, int kro, int vro, const bf16x8 (&qr)[4], State& st, LAS float* wsf, int r32, int hi,
                                          int q0w, int qi, bool past, bool bit, bool full_past) {
    constexpr int NB = (MODE == 0) ? 127 : 128;
    if (ta >= tb) return;
#define RR_KB(t) (lds + KOFF + ((t) - slot_base) * KSLOT + kro)
#define RR_VP(t) (lds + VOFF_B + ((t) - slot_base) * 8192 + vro)
#define RR_FULL(t) (past ? full_past : ((MODE == 2) ? (64 * (t) + 63 <= q0w) : ((64 * (t) + 63 <= q0w) && (q0w + 31 - 64 * (t) <= NB))))
    f32x16 a0, a1, b0, b1;
    if constexpr (!PIPE) {
        for (int t = ta; t < tb; ++t) { tile_s(RR_KB(t), qr, a0, a1); tile_finish<MODE>(a0, a1, RR_VP(t), st, wsf, r32, hi, 64 * t, qi, RR_FULL(t), past, bit); }
        return;
    }
    tile_s(RR_KB(ta), qr, a0, a1);
    int t = ta;
    for (;;) {
        if (t + 1 < tb) tile_s(RR_KB(t + 1), qr, b0, b1);
        tile_finish<MODE>(a0, a1, RR_VP(t), st, wsf, r32, hi, 64 * t, qi, RR_FULL(t), past, bit);
        if (++t >= tb) break;
        if (t + 1 < tb) tile_s(RR_KB(t + 1), qr, a0, a1);
        tile_finish<MODE>(b0, b1, RR_VP(t), st, wsf, r32, hi, 64 * t, qi, RR_FULL(t), past, bit);
        if (++t >= tb) break;
    }
#undef RR_KB
#undef RR_VP
#undef RR_FULL
}
template <int MODE>
__device__ __forceinline__ void epilogue(LAS unsigned char* lds, State& st, int wid, int lane, bf16_t* Ow, long ostride, int q0w, float sink2, float* lse_w, long lse_stride, int grp) {
    const int r32 = lane & 31, hi = lane >> 5;
    LAS float* wsf = (LAS float*)(lds + WSF) + wid * 128;
    float lsum = xhalf_sum(st.lsum);
    if constexpr (MODE == 0) lsum += __builtin_amdgcn_exp2f(sink2 - st.mref);
    if (hi == 0) { wsf[r32] = __builtin_amdgcn_rcpf(lsum); wsf[32 + r32] = st.mref + __builtin_amdgcn_logf(lsum); }
    asm volatile("s_waitcnt lgkmcnt(0)" ::: "memory");
    LAS bf16_t* stg = (LAS bf16_t*)(lds + OST) + wid * 2048;
#pragma unroll
    for (int r = 0; r < 16; ++r) {
        const int orow = crow(r, hi); const float il = wsf[orow];
        stg[orow * 64 + r32] = (bf16_t)(cvtpk(st.o0[r] * il, 0.f) & 0xffffu);
        stg[orow * 64 + 32 + r32] = (bf16_t)(cvtpk(st.o1[r] * il, 0.f) & 0xffffu);
    }
    asm volatile("s_waitcnt lgkmcnt(0)" ::: "memory");
#pragma unroll
    for (int i = 0; i < 4; ++i) {
        const int row = i * 8 + (lane >> 3), ch = lane & 7;
        u32x4 v = *(const LAS u32x4*)(stg + row * 64 + ch * 8);
        bf16_t* op = Ow + (long)(q0w + row) * ostride + ch * 8;
        if constexpr (MODE == 1) {
            float* lp = lse_w + (long)(q0w + row) * lse_stride;
            const float lb = wsf[32 + row];
            if (grp > 0) {
                const float la = *lp; const u32x4 ov = *(const u32x4*)op;
                const float L = fmaxf(la, lb), wa = __builtin_amdgcn_exp2f(la - L), wb = __builtin_amdgcn_exp2f(lb - L), inv = __builtin_amdgcn_rcpf(wa + wb);
                const float ca = wa * inv, cb = wb * inv;
#pragma unroll
                for (int j = 0; j < 4; ++j) {
                    const float a_lo = __uint_as_float(ov[j] << 16), a_hi = __uint_as_float(ov[j] & 0xffff0000u);
                    const float b_lo = __uint_as_float(v[j] << 16), b_hi = __uint_as_float(v[j] & 0xffff0000u);
                    v[j] = cvtpk(ca * a_lo + cb * b_lo, ca * a_hi + cb * b_hi);
                }
                if (ch == 0) *lp = L + __builtin_amdgcn_logf(wa + wb);
            } else if (ch == 0) *lp = lb;
        }
        *(u32x4*)op = v;
    }
    asm volatile("s_waitcnt lgkmcnt(0)" ::: "memory");
}

__device__ __forceinline__ void moba_phase(LAS unsigned char* lds, int vc, const bf16_t* QKV, bf16_t* OB) {
    int tid_ = threadIdx.x; asm volatile("" : "+v"(tid_));
    const int tid = tid_, lane = tid & 63, r32 = lane & 31, hi = lane >> 5;
    const int wid = __builtin_amdgcn_readfirstlane(tid >> 6);
    const int lkey = tid >> 3, lch = tid & 7;
    constexpr long kstride = 3072, qstride = 3072;
    const int bh = vc >> 1, set = vc & 1, b = bh >> 4, h = bh & 15;
    const bf16_t* base = QKV + (size_t)b * SEQ * 3072 + h * 64;
    bf16_t* Ob = OB + (size_t)b * SEQ * DM + h * 64;
    const bf16_t* kg = base + 1024 + (long)lkey * kstride + lch * 8;
    const bf16_t* vg = base + 2048 + (long)lkey * kstride + lch * 8;
    LAS float* km = (LAS float*)(lds + KM);
    for (int nb = 0; nb < 2; ++nb) {
        const int n = 2 * wid + nb;
        const bf16_t* kp = base + 1024 + (size_t)(256 * n + (lane >> 3)) * 3072 + (lane & 7) * 8;
        float sm[8];
#pragma unroll
        for (int j = 0; j < 8; ++j) sm[j] = 0.f;
        for (int i = 0; i < 32; ++i) { const u32x4 v = *(const u32x4*)(kp + (size_t)(8 * i) * 3072);
#pragma unroll
            for (int j = 0; j < 4; ++j) { sm[2 * j] += __uint_as_float(v[j] << 16); sm[2 * j + 1] += __uint_as_float(v[j] & 0xffff0000u); } }
#pragma unroll
        for (int j = 0; j < 8; ++j) { sm[j] += shflx(sm[j], 8, lane); sm[j] += shflx(sm[j], 16, lane); sm[j] += shflx(sm[j], 32, lane); }
        if (lane < 8) {
#pragma unroll
            for (int j = 0; j < 8; ++j) km[n * 64 + lane * 8 + j] = sm[j] * (1.0f / 256.0f); }
    }
#define MOBA_I(k) ((((k) & 1) ? 15 - (set + 2 * ((k) >> 1)) : (set + 2 * ((k) >> 1))))
    u32x4 kreg4[4], vreg4[4]; bf16x8 qr[4];
#pragma unroll
    for (int s_ = 0; s_ < 4; ++s_) { kreg4[s_] = *(const u32x4*)(kg + (long)(64 * s_) * kstride); vreg4[s_] = *(const u32x4*)(vg + (long)(64 * s_) * kstride); }
    { const bf16_t* qp = base + (long)(256 * MOBA_I(0) + 32 * wid + r32) * qstride + hi * 8;
#pragma unroll
      for (int d0 = 0; d0 < 4; ++d0) qr[d0] = *(const bf16x8*)(qp + d0 * 16); }
    __syncthreads();
    for (int k = 0; k < 8; ++k) {
        int t2_ = threadIdx.x; asm volatile("" : "+v"(t2_));
        const int tid = t2_, lane = tid & 63, r32 = lane & 31, hi = lane >> 5, lkey = tid >> 3, lch = tid & 7;
        const bf16_t* kg = base + 1024 + (long)lkey * kstride + lch * 8;
        const bf16_t* vg = base + 2048 + (long)lkey * kstride + lch * 8;
        const unsigned kw = lch * KCH + lkey * 16, vw = (lch >> 2) * 4096 + lkey * 64 + (lch & 3) * 16;
        LAS float* wsf = (LAS float*)(lds + WSF) + wid * 128;
        const int kro = hi * KCH + r32 * 16;
        const int vro = ((lane >> 4) & 1) * 32 + (lane & 3) * 8 + (4 * hi + ((lane & 15) >> 2)) * 64;
        const int blk_i = MOBA_I(k), q0w = 256 * blk_i + 32 * wid, qi = q0w + r32;
        unsigned sel = 0u;
        {
            float v0 = -INFINITY, v1 = -INFINITY, v2 = -INFINITY; int i0 = 0, i1 = 0, i2 = 0;
            for (int n = 0; n < blk_i; ++n) {
                float sg = 0.f;
#pragma unroll
                for (int d0 = 0; d0 < 4; ++d0) {
                    const f32x4 ka = *(const LAS f32x4*)(km + n * 64 + d0 * 16 + hi * 8), kb = *(const LAS f32x4*)(km + n * 64 + d0 * 16 + hi * 8 + 4);
#pragma unroll
                    for (int j = 0; j < 4; ++j) { sg += bf2f((unsigned short)qr[d0][j]) * ka[j]; sg += bf2f((unsigned short)qr[d0][4 + j]) * kb[j]; }
                }
                sg = xhalf_sum(sg);
                if (sg > v0) { v2 = v1; i2 = i1; v1 = v0; i1 = i0; v0 = sg; i0 = n; }
                else if (sg > v1) { v2 = v1; i2 = i1; v1 = sg; i1 = n; }
                else if (sg > v2) { v2 = sg; i2 = n; }
            }
            sel = (blk_i >= 1 ? (1u << i0) : 0u) | (blk_i >= 2 ? (1u << i1) : 0u) | (blk_i >= 3 ? (1u << i2) : 0u);
        }
        State st; st.mref = 0.f; st.lsum = 0.f;
#pragma unroll
        for (int r = 0; r < 16; ++r) { st.o0[r] = 0.f; st.o1[r] = 0.f; }
        for (int jb = 0; jb <= blk_i; ++jb) {
#pragma unroll
            for (int s_ = 0; s_ < 4; ++s_) { *(LAS u32x4*)(lds + KOFF + s_ * KSLOT + kw) = kreg4[s_]; *(LAS u32x4*)(lds + VOFF_B + s_ * 8192 + vw) = vreg4[s_]; }
            __syncthreads();
            if (jb < blk_i) {
#pragma unroll
                for (int s_ = 0; s_ < 4; ++s_) { kreg4[s_] = *(const u32x4*)(kg + (long)(64 * (4 * (jb + 1) + s_)) * kstride); vreg4[s_] = *(const u32x4*)(vg + (long)(64 * (4 * (jb + 1) + s_)) * kstride); }
            } else if (k + 1 < 8) {
#pragma unroll
                for (int s_ = 0; s_ < 4; ++s_) { kreg4[s_] = *(const u32x4*)(kg + (long)(64 * s_) * kstride); vreg4[s_] = *(const u32x4*)(vg + (long)(64 * s_) * kstride); }
            }
            const bool past = jb < blk_i;
            bool bit = true, need_blk = true, full_blk = false;
            if (past) { bit = (sel >> jb) & 1u; need_blk = __any(bit); full_blk = !__any(!bit); }
            if (need_blk) {
                const int tb = past ? 4 * jb + 4 : ((q0w + 31) >> 6) + 1;
                run_range<2, true>(lds, 4 * jb, tb, 4 * jb, kro, vro, qr, st, wsf, r32, hi, q0w, qi, past, bit, full_blk);
            }
            __syncthreads();
        }
        if (k + 1 < 8) {
            const bf16_t* qp = base + (long)(256 * MOBA_I(k + 1) + 32 * wid + r32) * qstride + hi * 8;
#pragma unroll
            for (int d0 = 0; d0 < 4; ++d0) qr[d0] = *(const bf16x8*)(qp + d0 * 16);
        }
        epilogue<2>(lds, st, wid, lane, Ob, DM, q0w, 0.f, nullptr, 0, 0);
    }
#undef MOBA_I
}

template <int MODE>
__device__ __forceinline__ void banded_phase(LAS unsigned char* lds, int vc, const bf16_t* QKV, bf16_t* OB, float* LSE, const float* sinks, int pass) {
    constexpr int NT = (MODE == 0) ? 3 : 6, NB = (MODE == 0) ? 127 : 128;
    int tid_ = threadIdx.x; asm volatile("" : "+v"(tid_));
    const int tid = tid_, lane = tid & 63, r32 = lane & 31, hi = lane >> 5;
    const int wid = __builtin_amdgcn_readfirstlane(tid >> 6);
    const int lkey = tid >> 3, lch = tid & 7;
    const int dil = (MODE == 0) ? 1 : ((pass == 0) ? 1 : (pass == 1) ? 4 : 16);
    const long ld = (MODE == 0) ? 1536 : 3072;
    const long kstride = (long)dil * ld;
    const unsigned kw = lch * KCH + lkey * 16, vw = (lch >> 2) * 4096 + lkey * 64 + (lch & 3) * 16;
    const int kro = hi * KCH + r32 * 16;
    const int vro = ((lane >> 4) & 1) * 32 + (lane & 3) * 8 + (4 * hi + ((lane & 15) >> 2)) * 64;
    LAS float* wsf = (LAS float*)(lds + WSF) + wid * 128;
    u32x4 kreg[NT], vreg[NT]; bf16x8 qn[4];
#define UNIT_DECODE(k) \
    const int u_ = vc * 8 + (k); const int b_ = u_ >> 8; \
    int hq_, hkv_, r_, q0_, thi_; \
    if (MODE == 0) { const int kvh = (u_ >> 6) & 3, qt = u_ & 63; hq_ = 4 * kvh + (wid >> 1); hkv_ = kvh; r_ = 0; q0_ = 64 * qt + 32 * (wid & 1); thi_ = qt + 1; } \
    else { const int xx = u_ & 15; hq_ = (u_ >> 4) & 15; hkv_ = hq_; r_ = xx % dil; const int jt = xx / dil; q0_ = 256 * jt + 32 * wid; thi_ = 4 * jt + 4; } \
    const bf16_t* base_ = QKV + ((size_t)b_ * SEQ + r_) * ld;
#define UNIT_LOAD(k) do { UNIT_DECODE(k) \
    const bf16_t* kg_ = base_ + 1024 + hkv_ * 64 + (long)lkey * kstride + lch * 8; const bf16_t* vg_ = kg_ + ((MODE == 0) ? 256 : 1024); \
    _Pragma("unroll") for (int s_ = 0; s_ < NT; ++s_) { int t_ = thi_ - NT + s_; t_ = t_ < 0 ? 0 : t_; kreg[s_] = *(const u32x4*)(kg_ + (long)(64 * t_) * kstride); vreg[s_] = *(const u32x4*)(vg_ + (long)(64 * t_) * kstride); } \
    const bf16_t* qp_ = base_ + hq_ * 64 + (long)(q0_ + r32) * kstride + hi * 8; \
    _Pragma("unroll") for (int d0 = 0; d0 < 4; ++d0) qn[d0] = *(const bf16x8*)(qp_ + d0 * 16); } while (0)
    UNIT_LOAD(0);
    for (int k = 0; k < 8; ++k) {
#pragma unroll
        for (int s_ = 0; s_ < NT; ++s_) { *(LAS u32x4*)(lds + KOFF + s_ * KSLOT + kw) = kreg[s_]; *(LAS u32x4*)(lds + VOFF_B + s_ * 8192 + vw) = vreg[s_]; }
        bf16x8 qr[4];
#pragma unroll
        for (int d0 = 0; d0 < 4; ++d0) qr[d0] = qn[d0];
        __syncthreads();
        if (k + 1 < 8) UNIT_LOAD(k + 1);
        UNIT_DECODE(k)
        const int qi = q0_ + r32, tlo = (thi_ - NT) < 0 ? 0 : (thi_ - NT);
        State st; st.mref = 0.f; st.lsum = 0.f;
#pragma unroll
        for (int r = 0; r < 16; ++r) { st.o0[r] = 0.f; st.o1[r] = 0.f; }
        {
            int ta = (q0_ - NB) >> 6; ta = ta < tlo ? tlo : ta;
            int tb = ((q0_ + 31) >> 6) + 1; tb = tb > thi_ ? thi_ : tb;
            run_range<MODE, MODE == 0>(lds, ta, tb, thi_ - NT, kro, vro, qr, st, wsf, r32, hi, q0_, qi, false, true, false);
        }
        float sink2 = 0.f; if (MODE == 0) sink2 = sinks[hq_] * LOG2E;
        epilogue<MODE>(lds, st, wid, lane, OB + ((size_t)b_ * SEQ + r_) * DM + hq_ * 64, (long)dil * DM, q0_, sink2, LSE + ((size_t)b_ * SEQ + r_) * 16 + hq_, (long)dil * 16, pass);
        __syncthreads();
    }
#undef UNIT_LOAD
#undef UNIT_DECODE
}
}

constexpr size_t MiB = 1u << 20;
constexpr size_t WS_W = 8 * MiB, WS_XN = 112 * MiB, WS_O = 176 * MiB, WS_LSE = 240 * MiB, WS_KM = 242 * MiB, WS_ROPE = 243 * MiB, WS_QKV = 246 * MiB, WS_END = 502 * MiB;
constexpr size_t W_AQKV = 0, W_AO = 3145728, W_BQKV = 5242880, W_BO = 14680064, W_CQKV = 15728640, W_CO = 18874368, W_GU = 19922944, W_DN = 42991616, W_TOTAL = 54525952;
static_assert(WS_W + W_TOTAL * 2 <= WS_XN, "weights region");
constexpr int LDS_BYTES = 147456;
static_assert(att::ATT_LDS <= 143360 && pg8::STAGE_BYTES + 8192 + 2048 <= 143360, "phase LDS below the barrier's two set-up words");

struct Args { const void* in[15]; float* out; unsigned char* ws; int ph_lo, ph_hi; };

__device__ __forceinline__ float wave_sum(float v) {
#pragma unroll
    for (int o = 1; o < 64; o <<= 1) v += __shfl_xor(v, o);
    return v;
}
__device__ __forceinline__ int rope_perm32(int l) { return (l < 16) ? ((l >> 1) + 8 * (l & 1)) : l; }
__device__ __forceinline__ void transpose_item(const float* W, int K, int Nsrc, bf16_t* WT, int k0, int ns0, int nd0, LAS float* scr, int lane, bool rperm) {
    const int sl = rperm ? rope_perm32(lane & 31) : (lane & 31);
    float tv[32];
    const float* wp = W + (size_t)(k0 + (lane >> 5)) * Nsrc + ns0 + sl;
#pragma unroll
    for (int i = 0; i < 32; ++i) tv[i] = wp[(size_t)(2 * i) * Nsrc];
#pragma unroll
    for (int i = 0; i < 32; ++i) scr[(2 * i + (lane >> 5)) * 33 + (lane & 31)] = tv[i];
    asm volatile("s_waitcnt lgkmcnt(0)" ::: "memory");
    const int c = lane & 7;
#pragma unroll
    for (int j = 0; j < 4; ++j) { const int n = (lane >> 3) + 8 * j; const LAS float* s = scr + (8 * c) * 33 + n;
        u32x4 o; o.x = cvtpk(s[0 * 33], s[1 * 33]); o.y = cvtpk(s[2 * 33], s[3 * 33]); o.z = cvtpk(s[4 * 33], s[5 * 33]); o.w = cvtpk(s[6 * 33], s[7 * 33]);
        *(u32x4*)(WT + (size_t)(nd0 + n) * K + k0 + 8 * c) = o; }
    asm volatile("s_waitcnt lgkmcnt(0)" ::: "memory");
}
__device__ __forceinline__ bool transpose_family(int& r, const float* src, bf16_t* dst, int nmat, int K, int N, bool gu, LAS float* scr, int lane, int rope_mode = 0) {
    const int nblk = N / 32, per = (K / 64) * nblk, tot = nmat * per;
    if (r >= tot) { r -= tot; return false; }
    const int mat = r / per, it = r % per, kb = it / nblk, nb = it % nblk;
    const int nd0 = 32 * nb; int ns0 = nd0;
    if (gu) { const int tile = nd0 >> 8, within = nd0 & 255; ns0 = (within >> 7) * DFF + tile * 128 + (within & 127); }
    const bool rperm = ((nd0 & 63) == 0) && ((rope_mode == 1 && nd0 < 1280) || (rope_mode == 2 && (nd0 % 3072) < 2048));
    transpose_item(src + (size_t)mat * K * N, K, N, dst + (size_t)mat * K * N, 64 * kb, ns0, nd0, scr, lane, rperm);
    return true;
}
__device__ __forceinline__ void sincos_tab(float ang, float& c, float& s) {
    const double a = (double)ang; const double n = __builtin_rint(a * 0.63661977236758134308);
    double r = __builtin_fma(-n, 1.57079632679489655800, a); r = __builtin_fma(-n, 6.12323399573676603587e-17, r);
    const float x = (float)r, x2 = x * x;
    const float sp = x * (1.f + x2 * (-1.6666667163e-1f + x2 * (8.3333337680e-3f + x2 * (-1.9841270114e-4f + x2 * 2.7557314297e-6f))));
    const float cp = 1.f + x2 * (-0.5f + x2 * (4.1666667908e-2f + x2 * (-1.3888889225e-3f + x2 * (2.4801587642e-5f + x2 * (-2.7557314297e-7f)))));
    const int q = ((int)n) & 3;
    const float ss = (q & 1) ? cp : sp, cc = (q & 1) ? sp : cp;
    s = (q & 2) ? -ss : ss; c = ((q + 1) & 2) ? -cc : cc;
}

#define XB_TMO      128
#define XB_XCNT(j)  (256  + 64 * (j))
#define XB_XSUB(j)  (1280 + 64 * (j))
#define XB_XGEN(j)  (2304 + 64 * (j))
#define XB_TOP      3328
#define XB_TOPGEN   3392
#define XCD_BAR_WORDS 3456
#define XB_SPIN_CAP (1u << 22)
__device__ __forceinline__ unsigned xb_ld(unsigned* p)              { return __hip_atomic_load(p, __ATOMIC_RELAXED, __HIP_MEMORY_SCOPE_AGENT); }
__device__ __forceinline__ unsigned xb_add(unsigned* p, unsigned v) { return __hip_atomic_fetch_add(p, v, __ATOMIC_RELAXED, __HIP_MEMORY_SCOPE_AGENT); }
__device__ __forceinline__ unsigned xb_xcc_id() { return (unsigned)__builtin_amdgcn_s_getreg((3 << 11) | 20) & 0xFu; }
#define XB_SPIN(cond, bar) do { unsigned _sp = 0; while (cond) { __builtin_amdgcn_s_sleep(1); \
    if ((++_sp & 255u) == 0u) { if (xb_ld(&(bar)[XB_TMO])) break; if (_sp > XB_SPIN_CAP) { atomicAdd(&(bar)[XB_TMO], 1u); break; } } } } while (0)
struct XcdBarrier { unsigned* bar; unsigned x; volatile LAS unsigned* st; };
__device__ __forceinline__ XcdBarrier xcd_barrier_post(unsigned* bar, volatile LAS unsigned* st) {
    XcdBarrier b; b.bar = bar; b.x = xb_xcc_id(); b.st = st;
    if (threadIdx.x == 0) (void)xb_add(&bar[XB_XCNT(b.x)], 1u);
    return b;
}
__device__ __forceinline__ void xcd_barrier_complete(unsigned* bar, unsigned x, unsigned& nloc, unsigned& nx) {
    const unsigned G = gridDim.x * gridDim.y * gridDim.z;
    unsigned sum, cnt, mine, sp = 0u;
    for (;;) {
        sum = 0u; cnt = 0u; mine = 0u;
#pragma unroll
        for (unsigned j = 0; j < 16; ++j) { const unsigned c = xb_ld(&bar[XB_XCNT(j)]); sum += c; cnt += (c > 0u) ? 1u : 0u; mine = (j == x) ? c : mine; }
        if (sum == G) break;
        __builtin_amdgcn_s_sleep(1);
        if ((++sp & 255u) == 0u) { if (xb_ld(&bar[XB_TMO])) break; if (sp > XB_SPIN_CAP) { atomicAdd(&bar[XB_TMO], 1u); break; } }
    }
    nloc = mine > 0u ? mine : 1u; nx = cnt > 0u ? cnt : 1u;
}
__device__ __forceinline__ void xcd_barrier(const XcdBarrier& b) {
    asm volatile("s_waitcnt vmcnt(0)" ::: "memory");
    __syncthreads();
    if (threadIdx.x == 0) {
        unsigned* bar = b.bar;
        __builtin_amdgcn_s_waitcnt(0);
        unsigned nloc = b.st[0], nx = b.st[1];
        if (nloc == 0u) { xcd_barrier_complete(bar, b.x, nloc, nx); b.st[0] = nloc; b.st[1] = nx; }
        const unsigned old = xb_add(&bar[XB_XSUB(b.x)], 1u);
        const unsigned gen = old / nloc;
        if (old + 1u == (gen + 1u) * nloc) {
            __builtin_amdgcn_fence(__ATOMIC_RELEASE, "agent");
            asm volatile("s_waitcnt vmcnt(0)" ::: "memory");
            const unsigned og = xb_add(&bar[XB_TOP], 1u);
            const unsigned tg = og / nx;
            if (og + 1u == (tg + 1u) * nx) xb_add(&bar[XB_TOPGEN], 1u);
            else XB_SPIN(xb_ld(&bar[XB_TOPGEN]) == tg, bar);
            __builtin_amdgcn_fence(__ATOMIC_ACQUIRE, "agent");
            xb_add(&bar[XB_XGEN(b.x)], 1u);
            asm volatile("s_waitcnt vmcnt(0)" ::: "memory");
        } else {
            XB_SPIN(xb_ld(&bar[XB_XGEN(b.x)]) == gen, bar);
            __builtin_amdgcn_fence(__ATOMIC_ACQUIRE, "agent");
            asm volatile("s_waitcnt vmcnt(0)" ::: "memory");
        }
    }
    __syncthreads();
}
constexpr int MISC_OFF = 143360;

__global__ void __launch_bounds__(512, 2) mega(Args args) {
    extern __shared__ __attribute__((aligned(16))) unsigned char lds_raw[];
    LAS unsigned char* lds = (LAS unsigned char*)lds_raw;
    cg::grid_group grid = cg::this_grid();
    const int tid0 = threadIdx.x, wave = __builtin_amdgcn_readfirstlane(tid0 >> 6);
#define LTID() int tid = threadIdx.x; asm volatile("" : "+v"(tid)); const int lane = tid & 63; (void)lane
    const int G = gridDim.x, bx = blockIdx.x;
    const int vcu = (G % 8 == 0) ? (bx % 8) * (G / 8) + bx / 8 : bx;
    const int gw = vcu * 8 + wave, NGW = G * 8;
    unsigned char* ws = args.ws;
    const float* x_in = (const float*)args.in[0]; const int* positions = (const int*)args.in[1];
    const float* ln_g = (const float*)args.in[2]; const float* ln_b = (const float*)args.in[3];
    float* out = args.out;
    bf16_t* Wb = (bf16_t*)(ws + WS_W); bf16_t* XN = (bf16_t*)(ws + WS_XN); bf16_t* OB = (bf16_t*)(ws + WS_O);
    float* LSE = (float*)(ws + WS_LSE); float* KMEAN = (float*)(ws + WS_KM); float* ROPE = (float*)(ws + WS_ROPE);
    bf16_t* QKV = (bf16_t*)(ws + WS_QKV); bf16_t* HB = QKV;
    float* BIASP = (float*)(ws + 3 * MiB);
    bf16_t* XLO = (bf16_t*)(ws + 438 * MiB);
    unsigned* CNT = (unsigned*)(ws + 1 * MiB); unsigned long long* XBUF = (unsigned long long*)(ws + 2 * MiB);
    const int lo = args.ph_lo, hi = args.ph_hi;
    int ph = 0;
    unsigned* BARW = (unsigned*)ws;
    if (tid0 < 2) ((volatile LAS unsigned*)(lds + MISC_OFF))[tid0] = 0u;
    if (bx == 0) { for (int i = tid0; i < XCD_BAR_WORDS; i += 512) __hip_atomic_store(BARW + i, 0u, __ATOMIC_RELAXED, __HIP_MEMORY_SCOPE_AGENT); }
    __syncthreads();
    XcdBarrier xbar; xbar.bar = BARW; xbar.x = 0; xbar.st = (volatile LAS unsigned*)(lds + MISC_OFF);
#define RUN() (ph >= lo && ph < hi)
#define SEAM() do { if (ph + 1 < hi) { if (ph == 0) { grid.sync(); xbar = xcd_barrier_post(BARW, (volatile LAS unsigned*)(lds + MISC_OFF)); } else xcd_barrier(xbar); } } while (0)

    if (RUN()) {
        LTID();
        LAS float* scr = (LAS float*)(lds + wave * 16384);
        constexpr int NITEMS = (int)(W_TOTAL / 2048);
        for (int it = gw; it < NITEMS; it += NGW) {
            int r = it;
            if (transpose_family(r, (const float*)args.in[4], Wb + W_AQKV, 2, DM, 1536, false, scr, lane, 1)) continue;
            if (transpose_family(r, (const float*)args.in[7], Wb + W_AO, 2, DM, DM, false, scr, lane)) continue;
            if (transpose_family(r, (const float*)args.in[9], Wb + W_BQKV, 1, DM, 9216, false, scr, lane, 2)) continue;
            if (transpose_family(r, (const float*)args.in[10], Wb + W_BO, 1, DM, DM, false, scr, lane)) continue;
            if (transpose_family(r, (const float*)args.in[11], Wb + W_CQKV, 1, DM, 3072, false, scr, lane, 2)) continue;
            if (transpose_family(r, (const float*)args.in[12], Wb + W_CO, 1, DM, DM, false, scr, lane)) continue;
            if (transpose_family(r, (const float*)args.in[13], Wb + W_GU, 4, DM, 2 * DFF, true, scr, lane)) continue;
            transpose_family(r, (const float*)args.in[14], Wb + W_DN, 4, DFF, DM, false, scr, lane);
        }
        for (int m = gw; m < MTOK; m += NGW) {
            const f32x4* xr = (const f32x4*)(x_in + (size_t)m * DM) + lane; u32x2* o8 = (u32x2*)(XN + (size_t)m * DM) + lane;
#pragma unroll
            for (int j = 0; j < 4; ++j) { const f32x4 v = xr[64 * j]; u32x2 w; w.x = cvtpk(v[0], v[1]); w.y = cvtpk(v[2], v[3]); o8[64 * j] = w; }
        }
        for (int e = vcu * 512 + tid; e < 8 * 128 * 64; e += G * 512) CNT[e] = 0u;
        for (int e = vcu * 512 + tid; e < 2 * 1536; e += G * 512) {
            const int c = e % 1536, l = c & 63; const int oc = (c < 1280 && l < 16) ? (c - l + rope_perm32(l)) : c;
            BIASP[e] = ((const float*)args.in[5])[e - c + oc];
        }
        for (int e = vcu * 512 + tid; e < MTOK * 8; e += G * 512) {
            const int m = e >> 3, j = e & 7;
            const float inv = (j == 0) ? 1.0f : (j == 1) ? 0.1939227432012558f : (j == 2) ? 0.03760603070259094f : (j == 3) ? 0.007292664609849453f : (j == 4) ? 0.0014142135623842478f
                            : (j == 5) ? 0.00027424818836152554f : (j == 6) ? 5.3182957344688475e-05f : 1.0313385246263351e-05f;
            const float ang = (float)positions[m] * inv;
            float c, s; sincos_tab(ang, c, s);
            ROPE[(size_t)m * 16 + j] = c; ROPE[(size_t)m * 16 + 8 + j] = s;
        }
        SEAM();
    }
    ++ph;

    for (int layer = 0; layer < DEPTH; ++layer) {
        const int kind = layer % 3, jj = layer / 3;
        const int npass = (kind == 1) ? 3 : 1;
        const int ncol = (kind == 0) ? 1536 : 3072;
        for (int pass = 0; pass < npass; ++pass) {
            if (RUN()) {
                const bf16_t* Wq = (kind == 0) ? Wb + W_AQKV + (size_t)jj * DM * 1536 : (kind == 1) ? Wb + W_BQKV + (size_t)pass * 3072 * DM : Wb + W_CQKV;
                pg8::Gemm g{XN, Wq, MTOK, ncol, DM}; pg8::StaticOrder S; S.init(MTOK, ncol, G, bx);
                pg8::EpiQKV E{QKV, ncol, (kind == 0) ? BIASP + (size_t)jj * 1536 : nullptr, (kind == 0) ? 1280 : 2048, 1024, ROPE};
                pg8::gemm_phase<pg8::EpiQKV, pg8::StaticOrder, true, true>(lds, g, S, E);
                SEAM();
            }
            ++ph;
            if (RUN()) {
                                for (int vc = vcu; vc < 256; vc += G) {
                    if (kind == 0) att::banded_phase<0>(lds, vc, QKV, OB, LSE, (const float*)args.in[6] + jj * 16, 0);
                    else if (kind == 1) att::banded_phase<1>(lds, vc, QKV, OB, LSE, nullptr, pass);
                    else {
                        att::moba_phase(lds, vc, QKV, OB);
                    }
                }
                SEAM();
            }
            ++ph;
        }
        for (int sub = 0; sub < 2; ++sub) {
            if (sub == 1) {
                if (RUN()) {
                    pg8::Gemm g{XN, Wb + W_GU + (size_t)layer * DM * 2 * DFF, MTOK, 2 * DFF, DM}; pg8::StaticOrder S; S.init(MTOK, 2 * DFF, G, bx);
                    pg8::EpiSwiGLU E{HB};
                    pg8::gemm_phase<pg8::EpiSwiGLU, pg8::StaticOrder, true, true>(lds, g, S, E);
                    SEAM();
                }
                ++ph;
            }
            if (RUN()) {
                const bf16_t* Wo = (kind == 0) ? Wb + W_AO + (size_t)jj * DM * DM : (kind == 1) ? Wb + W_BO : Wb + W_CO;
                const bf16_t* Wd = Wb + W_DN + (size_t)layer * DM * DFF;
                const float* bias = (sub == 0 && kind == 0) ? (const float*)args.in[8] + (size_t)jj * DM : nullptr;
                const float* xres = (layer == 0 && sub == 0) ? x_in : nullptr;
                float* outp = (layer == DEPTH - 1 && sub == 1) ? out : nullptr;
                const float* gp = ln_g + (size_t)(layer * 2 + sub) * DM; const float* bp = ln_b + (size_t)(layer * 2 + sub) * DM;
                pg8::Gemm g{sub == 0 ? OB : HB, sub == 0 ? Wo : Wd, MTOK, DM, sub == 0 ? DM : DFF};
                {
                    pg8::PanelStats st{XBUF, CNT + (size_t)(layer * 2 + sub) * 128 * 64};
                    pg8::EpiLN E{xres, outp, XN, XLO, bias, gp, bp, st, 1, (outp == nullptr) ? 1 : 0};
                    pg8::StaticOrder S; S.init(MTOK, DM, G, bx);
                    pg8::gemm_phase<pg8::EpiLN, pg8::StaticOrder, true, true>(lds, g, S, E);
                }
                SEAM();
            }
            ++ph;
        }
    }
#undef RUN
#undef SEAM
}

constexpr int NPHASE = 1 + 5 + 9 + 5 + 5;

extern "C" void kernel_launch(void* const* d_in, const int* in_sizes, int n_in, void* d_out, int out_size, void* d_ws, size_t ws_size, hipStream_t stream) {
    static int grid = 0;
    if (grid == 0) {
        if (n_in != 15 || out_size != MTOK * DM || ws_size < WS_END) { fprintf(stderr, "kernel_launch: unexpected shapes (n_in %d out %d ws %zu)\n", n_in, out_size, ws_size); grid = -1; return; }
        int dev = 0, cus = 0, per_cu = 0;
        (void)hipGetDevice(&dev); (void)hipDeviceGetAttribute(&cus, hipDeviceAttributeMultiprocessorCount, dev);
        if (hipFuncSetAttribute((const void*)mega, hipFuncAttributeMaxDynamicSharedMemorySize, LDS_BYTES) != hipSuccess) { fprintf(stderr, "kernel_launch: hipFuncSetAttribute failed\n"); grid = -1; return; }
        if (hipOccupancyMaxActiveBlocksPerMultiprocessor(&per_cu, (const void*)mega, 512, LDS_BYTES) != hipSuccess || per_cu < 1) { fprintf(stderr, "kernel_launch: occupancy query says %d\n", per_cu); per_cu = 1; }
        (void)hipGetLastError();
        grid = cus * per_cu;
        if (grid > 256) grid = 256;
    }
    if (grid < 0) return;
    Args a{};
    for (int i = 0; i < 15; ++i) a.in[i] = d_in[i];
    a.out = (float*)d_out; a.ws = (unsigned char*)d_ws;
#if MK_MULTI
    for (int p = 0; p < NPHASE; ++p) { a.ph_lo = p; a.ph_hi = p + 1; hipLaunchKernelGGL(mega, dim3(grid), dim3(512), LDS_BYTES, stream, a); }
#else
    a.ph_lo = 0; a.ph_hi = NPHASE;
    void* kargs[] = {&a};
    hipError_t e = hipLaunchCooperativeKernel((const void*)mega, dim3(grid), dim3(512), kargs, LDS_BYTES, stream);
    if (e != hipSuccess) fprintf(stderr, "cooperative launch failed: %s (grid %d)\n", hipGetErrorString(e), grid);
#endif
}
```

```cpp
#include <hip/hip_runtime.h>
#include <hip/hip_cooperative_groups.h>
#include <cstdio>
#include <cstdint>
namespace cg = cooperative_groups;

#define LAS __attribute__((address_space(3)))
typedef unsigned short bf16_t;
typedef short bf16x8 __attribute__((ext_vector_type(8)));
typedef float f32x4 __attribute__((ext_vector_type(4)));
typedef float f32x2 __attribute__((ext_vector_type(2)));
typedef float f32x16 __attribute__((ext_vector_type(16)));
typedef unsigned u32x4 __attribute__((ext_vector_type(4)));
typedef unsigned u32x2 __attribute__((ext_vector_type(2)));
typedef short s16x4 __attribute__((ext_vector_type(4)));
typedef __bf16 bf16x2_t __attribute__((ext_vector_type(2)));

#ifndef MK_MULTI
#define MK_MULTI 0
#endif

constexpr int BATCH = 8, SEQ = 4096, DM = 1024, MTOK = BATCH * SEQ, DFF = 2816, HD = 64, DEPTH = 4;
constexpr float DN_ALPHA = 1.6817928305074290861f;
constexpr float LN_EPS = 1e-5f;
constexpr float LOG2E = 1.4426950408889634f;
constexpr float QSCALE = 0.125f * LOG2E;

__device__ __forceinline__ unsigned cvtpk(float lo, float hi) { f32x2 v = {lo, hi}; bf16x2_t b = __builtin_convertvector(v, bf16x2_t); return __builtin_bit_cast(unsigned, b); }
__device__ __forceinline__ float shflx(float v, int mask, int lane) { return __int_as_float(__builtin_amdgcn_ds_bpermute((lane ^ mask) << 2, __float_as_int(v))); }
__device__ __forceinline__ float bf2f(unsigned short b) { return __uint_as_float(((unsigned)b) << 16); }

namespace pg8 {
constexpr int BM = 256, BK = 64, HALF = 128, HTB = HALF * BK * 2, STAGE_BYTES = 8 * HTB, NXCD = 8, WGM = 8;
__host__ __device__ __forceinline__ int lds_byte(int r, int c) { const int st = (r >> 4) * 2 + (c >> 5), rr = r & 15, cc = c & 31, ob = rr * 64 + cc * 2; return st * 1024 + (ob ^ (((ob >> 9) & 1) << 5)); }
__host__ __device__ __forceinline__ void stage_rc(int b, int& R, int& C) { const int st = b / 1024, sb = b % 1024, swz = sb ^ (((sb >> 9) & 1) << 5); R = (st >> 1) * 16 + swz / 64; C = (st & 1) * 32 + (swz % 64) / 2; }
__host__ __device__ __forceinline__ int perm32(int rho) { const int n = rho >> 4, i = rho & 15; return 8 * (i >> 2) + 4 * n + (i & 3); }
struct Unit { int pm, pn; };
struct Gemm { const bf16_t* A; const bf16_t* Bt; int M, N, K; };
struct StaticOrder {
    int nM, nN, nwg, G, c;
    __host__ __device__ void init(int M, int N, int G_, int c_) { nM = M / BM; nN = N / BM; nwg = nM * nN; G = G_; c = c_; }
    __host__ __device__ bool next(int i, Unit& u) const {
        const long L = (long)i * G + c; if (L >= nwg) return false;
        int wgid = (int)L; { const int q = nwg / NXCD, r = nwg % NXCD, xcd = wgid % NXCD, off = wgid / NXCD; wgid = (xcd < r ? xcd * (q + 1) : r * (q + 1) + (xcd - r) * q) + off; }
        const int nig = WGM * nN, gid = wgid / nig, fm = gid * WGM, gsz = (nM - fm) < WGM ? (nM - fm) : WGM;
        u.pm = fm + ((wgid % nig) % gsz); u.pn = (wgid % nig) / gsz; return true;
    }
};

struct EpiQKV {
    static constexpr bool PERM = true, AFTER_DRAIN = false, FUSED_MID = false;
    bf16_t* O; int ldc; const float* bias; int rope_cols, q_cols; const float* rope;
    __device__ __forceinline__ void operator()(const f32x4 (&acc)[2][2][4][2], const Unit& u, int wr, int wc, int fr, int fq) const {
        const int row0 = u.pm * BM + wr * 64 + fr, colt = u.pn * BM, col0 = colt + wc * 32 + 8 * fq;
        const bool do_rope = (colt < rope_cols) && ((wc & 1) == 0);
        const float sc = (colt < q_cols) ? QSCALE : 1.0f;
        f32x4 bv[2][2];
#pragma unroll
        for (int bj = 0; bj < 2; ++bj)
#pragma unroll
            for (int n = 0; n < 2; ++n) bv[bj][n] = bias ? *(const f32x4*)(bias + col0 + bj * HALF + 4 * n) : (f32x4){0.f, 0.f, 0.f, 0.f};
        u32x4 rw[2][4];
        if (do_rope) {
#pragma unroll
            for (int ai = 0; ai < 2; ++ai)
#pragma unroll
                for (int m = 0; m < 4; ++m) rw[ai][m] = *(const u32x4*)((const bf16_t*)rope + (size_t)(row0 + ai * HALF + m * 16) * 16 + 8 * (fq & 1));
        }
#pragma unroll
        for (int ai = 0; ai < 2; ++ai) {
#pragma unroll
            for (int m = 0; m < 4; ++m) {
                bf16_t* rowp = O + (size_t)(row0 + ai * HALF + m * 16) * ldc + col0;
#pragma unroll
                for (int bj = 0; bj < 2; ++bj) {
                    f32x4 v0 = acc[ai][bj][m][0] + bv[bj][0], v1 = acc[ai][bj][m][1] + bv[bj][1];
                    if (do_rope && fq < 2) {
                        const u32x4 q_ = rw[ai][m];
                        const f32x4 c = {__uint_as_float(q_.x << 16), __uint_as_float(q_.x & 0xffff0000u), __uint_as_float(q_.y << 16), __uint_as_float(q_.y & 0xffff0000u)};
                        const f32x4 s_ = {__uint_as_float(q_.z << 16), __uint_as_float(q_.z & 0xffff0000u), __uint_as_float(q_.w << 16), __uint_as_float(q_.w & 0xffff0000u)};
                        const f32x4 r0 = {v0[0] * c[0] - v0[1] * s_[0], v0[1] * c[0] + v0[0] * s_[0], v0[2] * c[1] - v0[3] * s_[1], v0[3] * c[1] + v0[2] * s_[1]};
                        const f32x4 r1 = {v1[0] * c[2] - v1[1] * s_[2], v1[1] * c[2] + v1[0] * s_[2], v1[2] * c[3] - v1[3] * s_[3], v1[3] * c[3] + v1[2] * s_[3]};
                        v0 = r0; v1 = r1;
                    }
                    v0 = v0 * sc; v1 = v1 * sc;
                    u32x4 w; w.x = cvtpk(v0[0], v0[1]); w.y = cvtpk(v0[2], v0[3]); w.z = cvtpk(v1[0], v1[1]); w.w = cvtpk(v1[2], v1[3]);
                    *(u32x4*)(rowp + bj * HALF) = w;
                }
            }
        }
    }
};
struct EpiResid {
    static constexpr bool PERM = false, AFTER_DRAIN = false, FUSED_MID = false;
    const float* xres; float* out; const float* bias;
    __device__ __forceinline__ void operator()(const f32x4 (&acc)[2][2][4][2], const Unit& u, int wr, int wc, int fr, int fq) const {
        const int col0 = u.pn * BM + wc * 32 + 4 * fq;
        f32x4 bv[2][2];
#pragma unroll
        for (int bj = 0; bj < 2; ++bj)
#pragma unroll
            for (int n = 0; n < 2; ++n) bv[bj][n] = bias ? *(const f32x4*)(bias + col0 + bj * HALF + n * 16) : (f32x4){0.f, 0.f, 0.f, 0.f};
#pragma unroll
        for (int ai = 0; ai < 2; ++ai)
#pragma unroll
            for (int m = 0; m < 4; ++m) {
                const size_t off = (size_t)(u.pm * BM + ai * HALF + wr * 64 + m * 16 + fr) * DM + col0;
#pragma unroll
                for (int bj = 0; bj < 2; ++bj)
#pragma unroll
                    for (int n = 0; n < 2; ++n) { const f32x4 bs = *(const f32x4*)(xres + off + bj * HALF + n * 16); *(f32x4*)(out + off + bj * HALF + n * 16) = bs * DN_ALPHA + (acc[ai][bj][m][n] + bv[bj][n]); }
            }
    }
};
struct EpiSwiGLU {
    static constexpr bool PERM = true, AFTER_DRAIN = false, FUSED_MID = false;
    bf16_t* H;
    __device__ __forceinline__ void operator()(const f32x4 (&acc)[2][2][4][2], const Unit& u, int wr, int wc, int fr, int fq) const {
        const int col0 = u.pn * HALF + wc * 32 + 8 * fq;
#pragma unroll
        for (int ai = 0; ai < 2; ++ai)
#pragma unroll
            for (int m = 0; m < 4; ++m) {
                bf16_t* rowp = H + (size_t)(u.pm * BM + ai * HALF + wr * 64 + m * 16 + fr) * DFF + col0;
                float h[8];
#pragma unroll
                for (int n = 0; n < 2; ++n)
#pragma unroll
                    for (int i = 0; i < 4; ++i) { const float g = acc[ai][0][m][n][i], up = acc[ai][1][m][n][i]; h[n * 4 + i] = g * __builtin_amdgcn_rcpf(1.0f + __builtin_amdgcn_exp2f(-g * LOG2E)) * up; }
                u32x4 w; w.x = cvtpk(h[0], h[1]); w.y = cvtpk(h[2], h[3]); w.z = cvtpk(h[4], h[5]); w.w = cvtpk(h[6], h[7]);
                *(u32x4*)rowp = w;
            }
    }
};

struct PanelStats {
    unsigned long long* xbuf;
    unsigned* cnt;
    __device__ __forceinline__ void run(const f32x4 (&v)[2][2][4][2], const Unit& u, int wr, int wc, int fr, int fq, LAS unsigned char* lds, int wid, int lane) const {
        LAS f32x2* P = (LAS f32x2*)(lds + STAGE_BYTES);
        LAS f32x2* S = (LAS f32x2*)(lds + STAGE_BYTES + 8192);
#pragma unroll
        for (int ai = 0; ai < 2; ++ai)
#pragma unroll
            for (int m = 0; m < 4; ++m) {
                float s = 0.f;
#pragma unroll
                for (int bj = 0; bj < 2; ++bj)
#pragma unroll
                    for (int n = 0; n < 2; ++n) { const f32x4 x = v[ai][bj][m][n]; s += (x[0] + x[1]) + (x[2] + x[3]); }
                s += shflx(s, 16, lane); s += shflx(s, 32, lane);
                const float mw = s * (1.0f / 64.0f); float q = 0.f;
#pragma unroll
                for (int bj = 0; bj < 2; ++bj)
#pragma unroll
                    for (int n = 0; n < 2; ++n) { const f32x4 d = v[ai][bj][m][n] - mw; q += (d[0] * d[0] + d[1] * d[1]) + (d[2] * d[2] + d[3] * d[3]); }
                q += shflx(q, 16, lane); q += shflx(q, 32, lane);
                if (fq == 0) P[(ai * HALF + wr * 64 + m * 16 + fr) * 4 + wc] = (f32x2){mw, q};
            }
        asm volatile("s_waitcnt lgkmcnt(0)" ::: "memory"); __builtin_amdgcn_s_barrier(); asm volatile("" ::: "memory");
        const int row = wid * 32 + (lane & 31);
        if (lane < 32) {
            const f32x2 a = P[row * 4 + 0], b = P[row * 4 + 1], c = P[row * 4 + 2], d = P[row * 4 + 3];
            const float mt = (a.x + b.x + c.x + d.x) * 0.25f;
            const float da = a.x - mt, db = b.x - mt, dc = c.x - mt, dd = d.x - mt;
            const float m2 = (a.y + b.y) + (c.y + d.y) + 64.0f * ((da * da + db * db) + (dc * dc + dd * dd));
            unsigned long long* slot = xbuf + ((size_t)(u.pm * BM + row) * 4 + u.pn);
            __hip_atomic_store(slot, ((unsigned long long)__float_as_uint(m2) << 32) | __float_as_uint(mt), __ATOMIC_RELAXED, __HIP_MEMORY_SCOPE_AGENT);
        }
        asm volatile("s_waitcnt vmcnt(0)" ::: "memory");
        if (lane == 0) __hip_atomic_fetch_add(cnt + 64 * u.pm, 1u, __ATOMIC_RELAXED, __HIP_MEMORY_SCOPE_AGENT);
        if (wid == 0) {
            unsigned sp = 0u;
            for (;;) {
                if ((unsigned)__builtin_amdgcn_readfirstlane(__hip_atomic_load(cnt + 64 * u.pm, __ATOMIC_RELAXED, __HIP_MEMORY_SCOPE_AGENT)) >= 32u) break;
                if (++sp > (1u << 24)) break;
                __builtin_amdgcn_s_sleep(2);
            }
            __builtin_amdgcn_fence(__ATOMIC_ACQUIRE, "agent");
        }
        asm volatile("s_waitcnt vmcnt(0) lgkmcnt(0)" ::: "memory"); __builtin_amdgcn_s_barrier(); asm volatile("" ::: "memory");
        if (lane < 32) {
            const unsigned long long* slot = xbuf + (size_t)(u.pm * BM + row) * 4; float mt[4], m2[4]; float ms = 0.f;
#pragma unroll
            for (int t = 0; t < 4; ++t) { const unsigned long long w = __hip_atomic_load(slot + t, __ATOMIC_RELAXED, __HIP_MEMORY_SCOPE_AGENT); mt[t] = __uint_as_float((unsigned)w); m2[t] = __uint_as_float((unsigned)(w >> 32)); ms += mt[t]; }
            const float mean = ms * 0.25f; float q = 0.f;
#pragma unroll
            for (int t = 0; t < 4; ++t) { const float dm = mt[t] - mean; q += m2[t] + 256.0f * dm * dm; }
            S[row] = (f32x2){mean, 1.0f / sqrtf(q * (1.0f / 1024.0f) + LN_EPS)};
        }
        asm volatile("s_waitcnt lgkmcnt(0)" ::: "memory"); __builtin_amdgcn_s_barrier(); asm volatile("" ::: "memory");
    }
};
struct EpiLN {
    static constexpr bool PERM = true, AFTER_DRAIN = false, FUSED_MID = true;
    const float* xres; float* out; bf16_t* xn; bf16_t* xlo; const float* bias; const float* gamma; const float* beta; PanelStats st; int rd_lo, wr_lo;
    __device__ __forceinline__ void fused(f32x4 (&acc)[2][2][4][2], const Unit& u, int wr, int wc, int fr, int fq, LAS unsigned char* lds, int wid, int lane) const {
        const LAS f32x2* S = (const LAS f32x2*)(lds + STAGE_BYTES + 8192);
        const int col0 = u.pn * BM + wc * 32 + 8 * fq;
#pragma unroll
        for (int bj = 0; bj < 2; ++bj)
#pragma unroll
            for (int n = 0; n < 2; ++n) { const f32x4 bv = bias ? *(const f32x4*)(bias + col0 + bj * HALF + 4 * n) : (f32x4){0.f, 0.f, 0.f, 0.f};
#pragma unroll
                for (int ai = 0; ai < 2; ++ai)
#pragma unroll
                    for (int m = 0; m < 4; ++m) acc[ai][bj][m][n] += bv; }
#pragma unroll
        for (int ab = 0; ab < 4; ++ab) {
            const int ai = ab >> 1, m0 = (ab & 1) * 2;
            f32x4 xr[2][2][2];
            if (xres) {
#pragma unroll
                for (int mm = 0; mm < 2; ++mm) { const size_t off = (size_t)(u.pm * BM + ai * HALF + wr * 64 + (m0 + mm) * 16 + fr) * DM + col0;
#pragma unroll
                    for (int bj = 0; bj < 2; ++bj)
#pragma unroll
                        for (int n = 0; n < 2; ++n) xr[mm][bj][n] = *(const f32x4*)(xres + off + bj * HALF + 4 * n); }
            } else {
                u32x4 xh[2][2], xl8[2];
#pragma unroll
                for (int mm = 0; mm < 2; ++mm) { const size_t off = (size_t)(u.pm * BM + ai * HALF + wr * 64 + (m0 + mm) * 16 + fr) * DM + col0;
#pragma unroll
                    for (int bj = 0; bj < 2; ++bj) xh[mm][bj] = *(const u32x4*)(xn + off + bj * HALF);
                    xl8[mm] = rd_lo ? *(const u32x4*)(xlo + (((size_t)(u.pm * 4 + u.pn) * 8 + ai * 4 + (m0 + mm)) * 512 + (wid * 64 + lane)) * 8) : (u32x4){0u, 0u, 0u, 0u}; }
#pragma unroll
                for (int mm = 0; mm < 2; ++mm)
#pragma unroll
                    for (int bj = 0; bj < 2; ++bj)
#pragma unroll
                        for (int n = 0; n < 2; ++n)
#pragma unroll
                            for (int i = 0; i < 2; ++i) { const unsigned h = xh[mm][bj][2 * n + i];
                                const f32x2 lr = i ? __builtin_amdgcn_cvt_pk_f32_bf8((int)xl8[mm][bj * 2 + n], true) : __builtin_amdgcn_cvt_pk_f32_bf8((int)xl8[mm][bj * 2 + n], false);
                                xr[mm][bj][n][2 * i] = __uint_as_float(h << 16) + lr[0] * (1.0f / 4096.0f); xr[mm][bj][n][2 * i + 1] = __uint_as_float(h & 0xffff0000u) + lr[1] * (1.0f / 4096.0f); }
            }
#pragma unroll
            for (int mm = 0; mm < 2; ++mm) { const int m = m0 + mm;
#pragma unroll
                for (int bj = 0; bj < 2; ++bj)
#pragma unroll
                    for (int n = 0; n < 2; ++n) acc[ai][bj][m][n] += xr[mm][bj][n] * DN_ALPHA;
                asm volatile("" : "+v"(acc[ai][0][m][0]), "+v"(acc[ai][0][m][1]), "+v"(acc[ai][1][m][0]), "+v"(acc[ai][1][m][1])); }
            asm volatile("" ::: "memory");
        }
        st.run(acc, u, wr, wc, fr, fq, lds, wid, lane);
        f32x4 gv[2][2], bt[2][2];
#pragma unroll
        for (int bj = 0; bj < 2; ++bj)
#pragma unroll
            for (int n = 0; n < 2; ++n) { gv[bj][n] = *(const f32x4*)(gamma + col0 + bj * HALF + 4 * n); bt[bj][n] = *(const f32x4*)(beta + col0 + bj * HALF + 4 * n); }
#pragma unroll
        for (int ai = 0; ai < 2; ++ai)
#pragma unroll
            for (int m = 0; m < 4; ++m) { const int r = ai * HALF + wr * 64 + m * 16 + fr; const f32x2 sr = S[r]; const size_t off = (size_t)(u.pm * BM + r) * DM + col0; u32x4 wl8;
#pragma unroll
                for (int bj = 0; bj < 2; ++bj) {
                    const f32x4 y0 = (acc[ai][bj][m][0] - sr.x) * sr.y * gv[bj][0] + bt[bj][0], y1 = (acc[ai][bj][m][1] - sr.x) * sr.y * gv[bj][1] + bt[bj][1];
                    if (out) { *(f32x4*)(out + off + bj * HALF) = y0; *(f32x4*)(out + off + bj * HALF + 4) = y1; }
                    u32x4 w; w.x = cvtpk(y0[0], y0[1]); w.y = cvtpk(y0[2], y0[3]); w.z = cvtpk(y1[0], y1[1]); w.w = cvtpk(y1[2], y1[3]);
                    if (!out) *(u32x4*)(xn + off + bj * HALF) = w;
                    { int d0 = __builtin_amdgcn_cvt_pk_bf8_f32((y0[0] - __uint_as_float(w.x << 16)) * 4096.0f, (y0[1] - __uint_as_float(w.x & 0xffff0000u)) * 4096.0f, 0, false);
                      d0 = __builtin_amdgcn_cvt_pk_bf8_f32((y0[2] - __uint_as_float(w.y << 16)) * 4096.0f, (y0[3] - __uint_as_float(w.y & 0xffff0000u)) * 4096.0f, d0, true);
                      int d1 = __builtin_amdgcn_cvt_pk_bf8_f32((y1[0] - __uint_as_float(w.z << 16)) * 4096.0f, (y1[1] - __uint_as_float(w.z & 0xffff0000u)) * 4096.0f, 0, false);
                      d1 = __builtin_amdgcn_cvt_pk_bf8_f32((y1[2] - __uint_as_float(w.w << 16)) * 4096.0f, (y1[3] - __uint_as_float(w.w & 0xffff0000u)) * 4096.0f, d1, true);
                      wl8[bj * 2] = (unsigned)d0; wl8[bj * 2 + 1] = (unsigned)d1; }
                    }
                if (wr_lo) *(u32x4*)(xlo + (((size_t)(u.pm * 4 + u.pn) * 8 + ai * 4 + m) * 512 + (wid * 64 + lane)) * 8) = wl8; }
        asm volatile("s_waitcnt lgkmcnt(0)" ::: "memory"); __builtin_amdgcn_s_barrier(); asm volatile("" ::: "memory");
    }
};
struct OneRound {
    StaticOrder S; int round;
    __device__ bool next(int i, Unit& u) const { return (i == 0) && S.next(round, u); }
};

template <class Epi, class Sched, bool ALIGN_EPI = false, bool SP2 = false>
__device__ __forceinline__ void gemm_phase(LAS unsigned char* lds, const Gemm g, const Sched& S, const Epi& E) {
    int tid_ = threadIdx.x; asm volatile("" : "+v"(tid_));
    const int tid = tid_, wid = __builtin_amdgcn_readfirstlane(tid >> 6), lane = tid & 63, wr = wid >> 2, wc = wid & 3, fr = lane & 15, fq = lane >> 4;
    const bf16_t* gA_ = g.A; const bf16_t* gB_ = g.Bt; asm volatile("" : "+s"(gA_), "+s"(gB_));
    const int K = g.K, nt = K / BK;
    unsigned voffA[2], voffB[2];
#pragma unroll
    for (int i = 0; i < 2; ++i) { int R, C; stage_rc(tid * 16 + i * 8192, R, C); const int Rb = Epi::PERM ? ((R & ~31) + perm32(R & 31)) : R;
        voffA[i] = (unsigned)(R * K + C) * 2u; voffB[i] = (unsigned)(Rb * K + C) * 2u; }
    const size_t kstep = (size_t)(BK * 2);
    const size_t hstep = (size_t)HALF * K * 2;
    const size_t tstep = 2 * hstep;
    const unsigned ldsw = (unsigned)wid * 1024u;
    const int aoff = lds_byte(wr * 64 + fr, fq * 8), boff = lds_byte(wc * 32 + fr, fq * 8);
#define PG8_SA(b, h) (((b) * 2 + (h)) * HTB)
#define PG8_SB(b, h) ((4 + (b) * 2 + (h)) * HTB)
#define PG8_STAGE(bufoff, gbase, voff) do { _Pragma("unroll") for (int _i = 0; _i < 2; ++_i) \
        __builtin_amdgcn_global_load_lds((const unsigned*)((const char*)(gbase) + (voff)[_i]), (LAS unsigned*)(lds + (bufoff) + ldsw + _i * 8192), 16, 0, 0); } while (0)
#define PG8_LDA(dst, b, h) do { _Pragma("unroll") for (int m = 0; m < 4; ++m) _Pragma("unroll") for (int k = 0; k < 2; ++k) dst[m][k] = *(const LAS bf16x8*)(lds + PG8_SA(b, h) + aoff + m * 2048 + k * 1024); } while (0)
#define PG8_LDB(dst, b, h) do { _Pragma("unroll") for (int n = 0; n < 2; ++n) _Pragma("unroll") for (int k = 0; k < 2; ++k) dst[n][k] = *(const LAS bf16x8*)(lds + PG8_SB(b, h) + boff + n * 2048 + k * 1024); } while (0)
#define PG8_MMA(ai, bj, At, Bt) do { __builtin_amdgcn_s_setprio(1); _Pragma("unroll") for (int m = 0; m < 4; ++m) _Pragma("unroll") for (int n = 0; n < 2; ++n) _Pragma("unroll") for (int k = 0; k < 2; ++k) \
        acc[ai][bj][m][n] = __builtin_amdgcn_mfma_f32_16x16x32_bf16(Bt[n][k], At[m][k], acc[ai][bj][m][n], 0, 0, 0); __builtin_amdgcn_s_setprio(0); } while (0)
#define PG8_WAIT_V(n) asm volatile("s_waitcnt vmcnt(" #n ")" ::: "memory")
#define PG8_WAIT_L(n) asm volatile("s_waitcnt lgkmcnt(" #n ")" ::: "memory")
#define PG8_BAR __builtin_amdgcn_s_barrier()
#define PG8_SCHED __builtin_amdgcn_sched_barrier(0)
    Unit cur, nxt; int ui = 0;
    if (!S.next(0, cur)) return;
    f32x4 acc[2][2][4][2];
#pragma unroll
    for (int a = 0; a < 2; ++a)
#pragma unroll
        for (int b = 0; b < 2; ++b)
#pragma unroll
            for (int m = 0; m < 4; ++m)
#pragma unroll
                for (int n = 0; n < 2; ++n) acc[a][b][m][n] = (f32x4){0.f, 0.f, 0.f, 0.f};
    bf16x8 At[4][2], B0[2][2], B1[2][2];
    const char* cA = (const char*)gA_ + (size_t)cur.pm * tstep; const char* cB = (const char*)gB_ + (size_t)cur.pn * tstep;
    if constexpr (SP2) {
        PG8_STAGE(PG8_SB(0, 0), cB, voffB); PG8_STAGE(PG8_SB(0, 1), cB + hstep, voffB); PG8_STAGE(PG8_SA(0, 0), cA, voffA); PG8_STAGE(PG8_SA(0, 1), cA + hstep, voffA);
        if (wr == 1) PG8_BAR;
        PG8_WAIT_V(2); PG8_BAR;
        PG8_STAGE(PG8_SB(1, 0), cB + kstep, voffB); PG8_STAGE(PG8_SA(1, 0), cA + kstep, voffA); PG8_STAGE(PG8_SB(1, 1), cB + hstep + kstep, voffB);
        PG8_WAIT_V(6); PG8_BAR;
    } else {
        PG8_STAGE(PG8_SB(0, 0), cB, voffB); PG8_STAGE(PG8_SA(0, 0), cA, voffA); PG8_STAGE(PG8_SB(0, 1), cB + hstep, voffB); PG8_STAGE(PG8_SA(0, 1), cA + hstep, voffA);
        if (wr == 1) PG8_BAR;
        PG8_WAIT_V(4); PG8_BAR;
        PG8_STAGE(PG8_SB(1, 0), cB + kstep, voffB); PG8_STAGE(PG8_SA(1, 0), cA + kstep, voffA); PG8_STAGE(PG8_SB(1, 1), cB + hstep + kstep, voffB);
        PG8_WAIT_V(6); PG8_BAR;
    }
    for (;;) {
        const bool has_next = S.next(ui + 1, nxt);
        const char* nA = has_next ? (const char*)gA_ + (size_t)nxt.pm * tstep : cA; const char* nB = has_next ? (const char*)gB_ + (size_t)nxt.pn * tstep : cB;
        for (int t = 0; t < nt; t += 2) {
            const bool last = (t == nt - 2);
            const char* a1 = cA + (size_t)(t + 1) * kstep;
            const char* a2 = last ? nA : cA + (size_t)(t + 2) * kstep; const char* b2 = last ? nB : cB + (size_t)(t + 2) * kstep;
            const char* a3 = a2 + kstep; const char* b3 = b2 + kstep;
            if constexpr (SP2) {
            PG8_LDB(B0, 0, 0); PG8_LDB(B1, 0, 1); PG8_SCHED; PG8_LDA(At, 0, 0); PG8_STAGE(PG8_SA(1, 1), a1 + hstep, voffA);
            PG8_WAIT_V(8); PG8_WAIT_L(0); PG8_BAR; PG8_MMA(0, 0, At, B0); PG8_MMA(0, 1, At, B1); PG8_BAR; PG8_SCHED;
            PG8_LDA(At, 0, 1); PG8_STAGE(PG8_SB(0, 0), b2, voffB); PG8_STAGE(PG8_SB(0, 1), b2 + hstep, voffB); PG8_STAGE(PG8_SA(0, 0), a2, voffA);
            PG8_WAIT_V(8); PG8_WAIT_L(0); PG8_BAR; PG8_MMA(1, 0, At, B0); PG8_MMA(1, 1, At, B1); PG8_BAR; PG8_SCHED;
            PG8_LDB(B0, 1, 0); PG8_LDB(B1, 1, 1); PG8_SCHED; PG8_LDA(At, 1, 0); PG8_STAGE(PG8_SA(0, 1), a2 + hstep, voffA);
            PG8_WAIT_V(8); PG8_WAIT_L(0); PG8_BAR; PG8_MMA(0, 0, At, B0); PG8_MMA(0, 1, At, B1); PG8_BAR; PG8_SCHED;
            PG8_LDA(At, 1, 1); PG8_STAGE(PG8_SB(1, 0), b3, voffB); PG8_STAGE(PG8_SB(1, 1), b3 + hstep, voffB); PG8_STAGE(PG8_SA(1, 0), a3, voffA);
            PG8_WAIT_V(8); PG8_WAIT_L(0); PG8_BAR; PG8_MMA(1, 0, At, B0); PG8_MMA(1, 1, At, B1); PG8_BAR; PG8_SCHED;
            } else {
            PG8_LDB(B0, 0, 0); PG8_SCHED; PG8_LDA(At, 0, 0); PG8_STAGE(PG8_SA(1, 1), a1 + hstep, voffA);
            PG8_WAIT_L(8); PG8_BAR; PG8_WAIT_L(0); PG8_MMA(0, 0, At, B0); PG8_BAR; PG8_SCHED;
            PG8_LDB(B1, 0, 1); PG8_STAGE(PG8_SB(0, 0), b2, voffB);
            PG8_BAR; PG8_WAIT_L(0); PG8_MMA(0, 1, At, B1); PG8_BAR;
            PG8_LDA(At, 0, 1); PG8_STAGE(PG8_SA(0, 0), a2, voffA);
            PG8_BAR; PG8_WAIT_L(0); PG8_MMA(1, 0, At, B0); PG8_BAR; PG8_SCHED;
            PG8_STAGE(PG8_SB(0, 1), b2 + hstep, voffB);
            PG8_WAIT_V(6); PG8_BAR; PG8_MMA(1, 1, At, B1); PG8_BAR;
            PG8_LDB(B0, 1, 0); PG8_SCHED; PG8_LDA(At, 1, 0); PG8_STAGE(PG8_SA(0, 1), a2 + hstep, voffA);
            PG8_WAIT_L(8); PG8_BAR; PG8_WAIT_L(0); PG8_MMA(0, 0, At, B0); PG8_BAR; PG8_SCHED;
            PG8_LDB(B1, 1, 1); PG8_STAGE(PG8_SB(1, 0), b3, voffB);
            PG8_BAR; PG8_WAIT_L(0); PG8_MMA(0, 1, At, B1); PG8_BAR;
            PG8_LDA(At, 1, 1); PG8_STAGE(PG8_SA(1, 0), a3, voffA);
            PG8_BAR; PG8_WAIT_L(0); PG8_MMA(1, 0, At, B0); PG8_BAR; PG8_SCHED;
            PG8_STAGE(PG8_SB(1, 1), b3 + hstep, voffB);
            PG8_WAIT_V(6); PG8_BAR; PG8_MMA(1, 1, At, B1); PG8_BAR;
            }
        }
        if constexpr (ALIGN_EPI) { if (wr == 0) PG8_BAR; }
        if constexpr (!Epi::AFTER_DRAIN) { if constexpr (Epi::FUSED_MID) E.fused(acc, cur, wr, wc, fr, fq, lds, wid, lane); else E(acc, cur, wr, wc, fr, fq); }
        if (!has_next) break;
#pragma unroll
        for (int a = 0; a < 2; ++a)
#pragma unroll
            for (int b = 0; b < 2; ++b)
#pragma unroll
                for (int m = 0; m < 4; ++m)
#pragma unroll
                    for (int n = 0; n < 2; ++n) acc[a][b][m][n] = (f32x4){0.f, 0.f, 0.f, 0.f};
        cur = nxt; cA = nA; cB = nB; ++ui;
        if constexpr (ALIGN_EPI) { if (wr == 1) PG8_BAR; }
    }
    PG8_WAIT_V(0);
    if constexpr (!ALIGN_EPI) { if (wr == 0) PG8_BAR; }
    PG8_BAR;
    if constexpr (Epi::AFTER_DRAIN) E.fused(acc, cur, wr, wc, fr, fq, lds, wid, lane);
#undef PG8_SA
#undef PG8_SB
#undef PG8_STAGE
#undef PG8_LDA
#undef PG8_LDB
#undef PG8_MMA
#undef PG8_WAIT_V
#undef PG8_WAIT_L
#undef PG8_BAR
#undef PG8_SCHED
}
}

namespace att {
constexpr int KCH = 1040, KSLOT = 8 * KCH  , KOFF = 0, VOFF_S = 16384, VOFF_B = 6 * KSLOT  , WSF = VOFF_B + 6 * 8192, OST = WSF + 4096, KM = OST + 32768, ATT_LDS = KM + 4096;
__device__ __forceinline__ int crow(int r, int hi) { return (r & 3) + 8 * (r >> 2) + 4 * hi; }
__device__ __forceinline__ float xhalf_max(float m) { auto rr = __builtin_amdgcn_permlane32_swap(__float_as_uint(m), __float_as_uint(m), false, false); return fmaxf(__uint_as_float(rr[0]), __uint_as_float(rr[1])); }
__device__ __forceinline__ float xhalf_sum(float m) { auto rr = __builtin_amdgcn_permlane32_swap(__float_as_uint(m), __float_as_uint(m), false, false); return __uint_as_float(rr[0]) + __uint_as_float(rr[1]); }
__device__ __forceinline__ s16x4 vtr(const LAS unsigned char* p) { return __builtin_bit_cast(s16x4, __builtin_amdgcn_ds_read_tr16_b64_v4i16((LAS s16x4*)p)); }
struct State { float mref, lsum; f32x16 o0, o1; };

__device__ __forceinline__ void tile_s(const LAS unsigned char* kb, const bf16x8 (&qr)[4], f32x16& p0, f32x16& p1) {
    {
        const f32x16 z = {0.f, 0.f, 0.f, 0.f, 0.f, 0.f, 0.f, 0.f, 0.f, 0.f, 0.f, 0.f, 0.f, 0.f, 0.f, 0.f};
        const bf16x8 a0 = *(const LAS bf16x8*)(kb), a1 = *(const LAS bf16x8*)(kb + 512);
        p0 = __builtin_amdgcn_mfma_f32_32x32x16_bf16(a0, qr[0], z, 0, 0, 0);
        p1 = __builtin_amdgcn_mfma_f32_32x32x16_bf16(a1, qr[0], z, 0, 0, 0);
    }
#pragma unroll
    for (int d0 = 1; d0 < 4; ++d0) {
        const bf16x8 a0 = *(const LAS bf16x8*)(kb + d0 * 2 * KCH), a1 = *(const LAS bf16x8*)(kb + d0 * 2 * KCH + 512);
        p0 = __builtin_amdgcn_mfma_f32_32x32x16_bf16(a0, qr[d0], p0, 0, 0, 0);
        p1 = __builtin_amdgcn_mfma_f32_32x32x16_bf16(a1, qr[d0], p1, 0, 0, 0);
    }
}
template <int MODE>
__device__ __forceinline__ void tile_finish(f32x16& p0, f32x16& p1, const LAS unsigned char* vp, State& st, LAS float* wsf, int r32, int hi, int k0, int qi, bool full, bool past, bool bit) {
    constexpr int NB = (MODE == 0) ? 127 : 128;
    if (__any(st.mref != 0.f)) {
#pragma unroll
        for (int r = 0; r < 16; ++r) { p0[r] -= st.mref; p1[r] -= st.mref; }
    }
    if (!full) {
        if (MODE == 2 && past) {
        } else {
#pragma unroll
            for (int r = 0; r < 16; ++r) {
                const int kk = k0 + crow(r, hi);
                bool ok0 = (kk <= qi), ok1 = (kk + 32 <= qi);
                if (MODE != 2) { ok0 = ok0 && (kk >= qi - NB); ok1 = ok1 && (kk + 32 >= qi - NB); }
                if (!ok0) p0[r] = -INFINITY;
                if (!ok1) p1[r] = -INFINITY;
            }
        }
    }
    float rm = fmaxf(p0[0], p1[0]);
#pragma unroll
    for (int r = 1; r < 16; ++r) rm = __builtin_fmaxf(__builtin_fmaxf(rm, p0[r]), p1[r]);
    rm = xhalf_max(rm);
    if (__any(rm > 8.0f)) {
        const float dl = fmaxf(rm, 0.f);
        st.mref += dl;
#pragma unroll
        for (int r = 0; r < 16; ++r) { p0[r] -= dl; p1[r] -= dl; }
        const float f = __builtin_amdgcn_exp2f(-dl);
        st.lsum *= f;
        if (hi == 0) wsf[r32] = f;
        asm volatile("s_waitcnt lgkmcnt(0)" ::: "memory");
#pragma unroll
        for (int r = 0; r < 16; ++r) { const float fr_ = wsf[crow(r, hi)]; st.o0[r] *= fr_; st.o1[r] *= fr_; }
        asm volatile("s_waitcnt lgkmcnt(0)" ::: "memory");
    }
#pragma unroll
    for (int r = 0; r < 16; ++r) { p0[r] = __builtin_amdgcn_exp2f(p0[r]); p1[r] = __builtin_amdgcn_exp2f(p1[r]); }
    float ps;
    { const f32x16 sv = p0 + p1; const f32x4 s4 = (f32x4){sv[0], sv[1], sv[2], sv[3]} + (f32x4){sv[4], sv[5], sv[6], sv[7]} + (f32x4){sv[8], sv[9], sv[10], sv[11]} + (f32x4){sv[12], sv[13], sv[14], sv[15]};
      ps = (s4[0] + s4[1]) + (s4[2] + s4[3]); }
    u32x4 pw[4];
#pragma unroll
    for (int j = 0; j < 4; ++j) { pw[0][j] = cvtpk(p0[2 * j], p0[2 * j + 1]); pw[1][j] = cvtpk(p0[8 + 2 * j], p0[9 + 2 * j]); pw[2][j] = cvtpk(p1[2 * j], p1[2 * j + 1]); pw[3][j] = cvtpk(p1[8 + 2 * j], p1[9 + 2 * j]); }
    if (MODE == 2 && past && !full) {
        const unsigned km = bit ? 0xffffffffu : 0u;
#pragma unroll
        for (int k = 0; k < 4; ++k) { pw[k][0] &= km; pw[k][1] &= km; pw[k][2] &= km; pw[k][3] &= km; }
        ps = bit ? ps : 0.f;
    }
    st.lsum += ps;
#pragma unroll
    for (int ks = 0; ks < 4; ++ks) {
        const bf16x8 pa = __builtin_bit_cast(bf16x8, pw[ks]);
        { const s16x4 lo = vtr(vp + ks * 1024), hh = vtr(vp + ks * 1024 + 512);
          const bf16x8 vb = {lo[0], lo[1], lo[2], lo[3], hh[0], hh[1], hh[2], hh[3]};
          st.o0 = __builtin_amdgcn_mfma_f32_32x32x16_bf16(pa, vb, st.o0, 0, 0, 0); }
        { const s16x4 lo = vtr(vp + 4096 + ks * 1024), hh = vtr(vp + 4096 + ks * 1024 + 512);
          const bf16x8 vb = {lo[0], lo[1], lo[2], lo[3], hh[0], hh[1], hh[2], hh[3]};
          st.o1 = __builtin_amdgcn_mfma_f32_32x32x16_bf16(pa, vb, st.o1, 0, 0, 0); }
    }
}
template <int MODE, bool PIPE>
__device__ __forceinline__ void run_range(LAS unsigned char* lds, int ta, int tb, int slot_base, int kro, int vro, const bf16x8 (&qr)[4], State& st, LAS float* wsf, int r32, int hi,
                                          int q0w, int qi, bool past, bool bit, bool full_past) {
    constexpr int NB = (MODE == 0) ? 127 : 128;
    if (ta >= tb) return;
#define RR_KB(t) (lds + KOFF + ((t) - slot_base) * KSLOT + kro)
#define RR_VP(t) (lds + VOFF_B + ((t) - slot_base) * 8192 + vro)
#define RR_FULL(t) (past ? full_past : ((MODE == 2) ? (64 * (t) + 63 <= q0w) : ((64 * (t) + 63 <= q0w) && (q0w + 31 - 64 * (t) <= NB))))
    f32x16 a0, a1, b0, b1;
    if constexpr (!PIPE) {
        for (int t = ta; t < tb; ++t) { tile_s(RR_KB(t), qr, a0, a1); tile_finish<MODE>(a0, a1, RR_VP(t), st, wsf, r32, hi, 64 * t, qi, RR_FULL(t), past, bit); }
        return;
    }
    tile_s(RR_KB(ta), qr, a0, a1);
    int t = ta;
    for (;;) {
        if (t + 1 < tb) tile_s(RR_KB(t + 1), qr, b0, b1);
        tile_finish<MODE>(a0, a1, RR_VP(t), st, wsf, r32, hi, 64 * t, qi, RR_FULL(t), past, bit);
        if (++t >= tb) break;
        if (t + 1 < tb) tile_s(RR_KB(t + 1), qr, a0, a1);
        tile_finish<MODE>(b0, b1, RR_VP(t), st, wsf, r32, hi, 64 * t, qi, RR_FULL(t), past, bit);
        if (++t >= tb) break;
    }
#undef RR_KB
#undef RR_VP
#undef RR_FULL
}
template <int MODE>
__device__ __forceinline__ void epilogue(LAS unsigned char* lds, State& st, int wid, int lane, bf16_t* Ow, long ostride, int q0w, float sink2, float* lse_w, long lse_stride, int grp) {
    const int r32 = lane & 31, hi = lane >> 5;
    LAS float* wsf = (LAS float*)(lds + WSF) + wid * 128;
    float lsum = xhalf_sum(st.lsum);
    if constexpr (MODE == 0) lsum += __builtin_amdgcn_exp2f(sink2 - st.mref);
    if (hi == 0) { wsf[r32] = __builtin_amdgcn_rcpf(lsum); wsf[32 + r32] = st.mref + __builtin_amdgcn_logf(lsum); }
    asm volatile("s_waitcnt lgkmcnt(0)" ::: "memory");
    LAS bf16_t* stg = (LAS bf16_t*)(lds + OST) + wid * 2048;
#pragma unroll
    for (int r = 0; r < 16; ++r) {
        const int orow = crow(r, hi); const float il = wsf[orow];
        stg[orow * 64 + r32] = (bf16_t)(cvtpk(st.o0[r] * il, 0.f) & 0xffffu);
        stg[orow * 64 + 32 + r32] = (bf16_t)(cvtpk(st.o1[r] * il, 0.f) & 0xffffu);
    }
    asm volatile("s_waitcnt lgkmcnt(0)" ::: "memory");
#pragma unroll
    for (int i = 0; i < 4; ++i) {
        const int row = i * 8 + (lane >> 3), ch = lane & 7;
        u32x4 v = *(const LAS u32x4*)(stg + row * 64 + ch * 8);
        bf16_t* op = Ow + (long)(q0w + row) * ostride + ch * 8;
        if constexpr (MODE == 1) {
            float* lp = lse_w + (long)(q0w + row) * lse_stride;
            const float lb = wsf[32 + row];
            if (grp > 0) {
                const float la = *lp; const u32x4 ov = *(const u32x4*)op;
                const float L = fmaxf(la, lb), wa = __builtin_amdgcn_exp2f(la - L), wb = __builtin_amdgcn_exp2f(lb - L), inv = __builtin_amdgcn_rcpf(wa + wb);
                const float ca = wa * inv, cb = wb * inv;
#pragma unroll
                for (int j = 0; j < 4; ++j) {
                    const float a_lo = __uint_as_float(ov[j] << 16), a_hi = __uint_as_float(ov[j] & 0xffff0000u);
                    const float b_lo = __uint_as_float(v[j] << 16), b_hi = __uint_as_float(v[j] & 0xffff0000u);
                    v[j] = cvtpk(ca * a_lo + cb * b_lo, ca * a_hi + cb * b_hi);
                }
                if (ch == 0) *lp = L + __builtin_amdgcn_logf(wa + wb);
            } else if (ch == 0) *lp = lb;
        }
        *(u32x4*)op = v;
    }
    asm volatile("s_waitcnt lgkmcnt(0)" ::: "memory");
}

__device__ __forceinline__ void moba_phase(LAS unsigned char* lds, int vc, const bf16_t* QKV, bf16_t* OB) {
    int tid_ = threadIdx.x; asm volatile("" : "+v"(tid_));
    const int tid = tid_, lane = tid & 63, r32 = lane & 31, hi = lane >> 5;
    const int wid = __builtin_amdgcn_readfirstlane(tid >> 6);
    const int lkey = tid >> 3, lch = tid & 7;
    constexpr long kstride = 3072, qstride = 3072;
    const int bh = vc >> 1, set = vc & 1, b = bh >> 4, h = bh & 15;
    const bf16_t* base = QKV + (size_t)b * SEQ * 3072 + h * 64;
    bf16_t* Ob = OB + (size_t)b * SEQ * DM + h * 64;
    const bf16_t* kg = base + 1024 + (long)lkey * kstride + lch * 8;
    const bf16_t* vg = base + 2048 + (long)lkey * kstride + lch * 8;
    LAS float* km = (LAS float*)(lds + KM);
    for (int nb = 0; nb < 2; ++nb) {
        const int n = 2 * wid + nb;
        const bf16_t* kp = base + 1024 + (size_t)(256 * n + (lane >> 3)) * 3072 + (lane & 7) * 8;
        float sm[8];
#pragma unroll
        for (int j = 0; j < 8; ++j) sm[j] = 0.f;
        for (int i = 0; i < 32; ++i) { const u32x4 v = *(const u32x4*)(kp + (size_t)(8 * i) * 3072);
#pragma unroll
            for (int j = 0; j < 4; ++j) { sm[2 * j] += __uint_as_float(v[j] << 16); sm[2 * j + 1] += __uint_as_float(v[j] & 0xffff0000u); } }
#pragma unroll
        for (int j = 0; j < 8; ++j) { sm[j] += shflx(sm[j], 8, lane); sm[j] += shflx(sm[j], 16, lane); sm[j] += shflx(sm[j], 32, lane); }
        if (lane < 8) {
#pragma unroll
            for (int j = 0; j < 8; ++j) km[n * 64 + lane * 8 + j] = sm[j] * (1.0f / 256.0f); }
    }
#define MOBA_I(k) ((((k) & 1) ? 15 - (set + 2 * ((k) >> 1)) : (set + 2 * ((k) >> 1))))
    u32x4 kreg4[4], vreg4[4]; bf16x8 qr[4];
#pragma unroll
    for (int s_ = 0; s_ < 4; ++s_) { kreg4[s_] = *(const u32x4*)(kg + (long)(64 * s_) * kstride); vreg4[s_] = *(const u32x4*)(vg + (long)(64 * s_) * kstride); }
    { const bf16_t* qp = base + (long)(256 * MOBA_I(0) + 32 * wid + r32) * qstride + hi * 8;
#pragma unroll
      for (int d0 = 0; d0 < 4; ++d0) qr[d0] = *(const bf16x8*)(qp + d0 * 16); }
    __syncthreads();
    for (int k = 0; k < 8; ++k) {
        int t2_ = threadIdx.x; asm volatile("" : "+v"(t2_));
        const int tid = t2_, lane = tid & 63, r32 = lane & 31, hi = lane >> 5, lkey = tid >> 3, lch = tid & 7;
        const bf16_t* kg = base + 1024 + (long)lkey * kstride + lch * 8;
        const bf16_t* vg = base + 2048 + (long)lkey * kstride + lch * 8;
        const unsigned kw = lch * KCH + lkey * 16, vw = (lch >> 2) * 4096 + lkey * 64 + (lch & 3) * 16;
        LAS float* wsf = (LAS float*)(lds + WSF) + wid * 128;
        const int kro = hi * KCH + r32 * 16;
        const int vro = ((lane >> 4) & 1) * 32 + (lane & 3) * 8 + (4 * hi + ((lane & 15) >> 2)) * 64;
        const int blk_i = MOBA_I(k), q0w = 256 * blk_i + 32 * wid, qi = q0w + r32;
        unsigned sel = 0u;
        {
            float v0 = -INFINITY, v1 = -INFINITY, v2 = -INFINITY; int i0 = 0, i1 = 0, i2 = 0;
            for (int n = 0; n < blk_i; ++n) {
                float sg = 0.f;
#pragma unroll
                for (int d0 = 0; d0 < 4; ++d0) {
                    const f32x4 ka = *(const LAS f32x4*)(km + n * 64 + d0 * 16 + hi * 8), kb = *(const LAS f32x4*)(km + n * 64 + d0 * 16 + hi * 8 + 4);
#pragma unroll
                    for (int j = 0; j < 4; ++j) { sg += bf2f((unsigned short)qr[d0][j]) * ka[j]; sg += bf2f((unsigned short)qr[d0][4 + j]) * kb[j]; }
                }
                sg = xhalf_sum(sg);
                if (sg > v0) { v2 = v1; i2 = i1; v1 = v0; i1 = i0; v0 = sg; i0 = n; }
                else if (sg > v1) { v2 = v1; i2 = i1; v1 = sg; i1 = n; }
                else if (sg > v2) { v2 = sg; i2 = n; }
            }
            sel = (blk_i >= 1 ? (1u << i0) : 0u) | (blk_i >= 2 ? (1u << i1) : 0u) | (blk_i >= 3 ? (1u << i2) : 0u);
        }
        State st; st.mref = 0.f; st.lsum = 0.f;
#pragma unroll
        for (int r = 0; r < 16; ++r) { st.o0[r] = 0.f; st.o1[r] = 0.f; }
        for (int jb = 0; jb <= blk_i; ++jb) {
#pragma unroll
            for (int s_ = 0; s_ < 4; ++s_) { *(LAS u32x4*)(lds + KOFF + s_ * KSLOT + kw) = kreg4[s_]; *(LAS u32x4*)(lds + VOFF_B + s_ * 8192 + vw) = vreg4[s_]; }
            __syncthreads();
            if (jb < blk_i) {
#pragma unroll
                for (int s_ = 0; s_ < 4; ++s_) { kreg4[s_] = *(const u32x4*)(kg + (long)(64 * (4 * (jb + 1) + s_)) * kstride); vreg4[s_] = *(const u32x4*)(vg + (long)(64 * (4 * (jb + 1) + s_)) * kstride); }
            } else if (k + 1 < 8) {
#pragma unroll
                for (int s_ = 0; s_ < 4; ++s_) { kreg4[s_] = *(const u32x4*)(kg + (long)(64 * s_) * kstride); vreg4[s_] = *(const u32x4*)(vg + (long)(64 * s_) * kstride); }
            }
            const bool past = jb < blk_i;
            bool bit = true, need_blk = true, full_blk = false;
            if (past) { bit = (sel >> jb) & 1u; need_blk = __any(bit); full_blk = !__any(!bit); }
            if (need_blk) {
                const int tb = past ? 4 * jb + 4 : ((q0w + 31) >> 6) + 1;
                run_range<2, true>(lds, 4 * jb, tb, 4 * jb, kro, vro, qr, st, wsf, r32, hi, q0w, qi, past, bit, full_blk);
            }
            __syncthreads();
        }
        if (k + 1 < 8) {
            const bf16_t* qp = base + (long)(256 * MOBA_I(k + 1) + 32 * wid + r32) * qstride + hi * 8;
#pragma unroll
            for (int d0 = 0; d0 < 4; ++d0) qr[d0] = *(const bf16x8*)(qp + d0 * 16);
        }
        epilogue<2>(lds, st, wid, lane, Ob, DM, q0w, 0.f, nullptr, 0, 0);
    }
#undef MOBA_I
}

template <int MODE>
__device__ __forceinline__ void banded_phase(LAS unsigned char* lds, int vc, const bf16_t* QKV, bf16_t* OB, float* LSE, const float* sinks, int pass) {
    constexpr int NT = (MODE == 0) ? 3 : 6, NB = (MODE == 0) ? 127 : 128;
    int tid_ = threadIdx.x; asm volatile("" : "+v"(tid_));
    const int tid = tid_, lane = tid & 63, r32 = lane & 31, hi = lane >> 5;
    const int wid = __builtin_amdgcn_readfirstlane(tid >> 6);
    const int lkey = tid >> 3, lch = tid & 7;
    const int dil = (MODE == 0) ? 1 : ((pass == 0) ? 1 : (pass == 1) ? 4 : 16);
    const long ld = (MODE == 0) ? 1536 : 3072;
    const long kstride = (long)dil * ld;
    const unsigned kw = lch * KCH + lkey * 16, vw = (lch >> 2) * 4096 + lkey * 64 + (lch & 3) * 16;
    const int kro = hi * KCH + r32 * 16;
    const int vro = ((lane >> 4) & 1) * 32 + (lane & 3) * 8 + (4 * hi + ((lane & 15) >> 2)) * 64;
    LAS float* wsf = (LAS float*)(lds + WSF) + wid * 128;
    u32x4 kreg[NT], vreg[NT]; bf16x8 qn[4];
#define UNIT_DECODE(k) \
    const int u_ = vc * 8 + (k); const int b_ = u_ >> 8; \
    int hq_, hkv_, r_, q0_, thi_; \
    if (MODE == 0) { const int kvh = (u_ >> 6) & 3, qt = u_ & 63; hq_ = 4 * kvh + (wid >> 1); hkv_ = kvh; r_ = 0; q0_ = 64 * qt + 32 * (wid & 1); thi_ = qt + 1; } \
    else { const int xx = u_ & 15; hq_ = (u_ >> 4) & 15; hkv_ = hq_; r_ = xx % dil; const int jt = xx / dil; q0_ = 256 * jt + 32 * wid; thi_ = 4 * jt + 4; } \
    const bf16_t* base_ = QKV + ((size_t)b_ * SEQ + r_) * ld;
#define UNIT_LOAD(k) do { UNIT_DECODE(k) \
    const bf16_t* kg_ = base_ + 1024 + hkv_ * 64 + (long)lkey * kstride + lch * 8; const bf16_t* vg_ = kg_ + ((MODE == 0) ? 256 : 1024); \
    _Pragma("unroll") for (int s_ = 0; s_ < NT; ++s_) { int t_ = thi_ - NT + s_; t_ = t_ < 0 ? 0 : t_; kreg[s_] = *(const u32x4*)(kg_ + (long)(64 * t_) * kstride); vreg[s_] = *(const u32x4*)(vg_ + (long)(64 * t_) * kstride); } \
    const bf16_t* qp_ = base_ + hq_ * 64 + (long)(q0_ + r32) * kstride + hi * 8; \
    _Pragma("unroll") for (int d0 = 0; d0 < 4; ++d0) qn[d0] = *(const bf16x8*)(qp_ + d0 * 16); } while (0)
    UNIT_LOAD(0);
    for (int k = 0; k < 8; ++k) {
#pragma unroll
        for (int s_ = 0; s_ < NT; ++s_) { *(LAS u32x4*)(lds + KOFF + s_ * KSLOT + kw) = kreg[s_]; *(LAS u32x4*)(lds + VOFF_B + s_ * 8192 + vw) = vreg[s_]; }
        bf16x8 qr[4];
#pragma unroll
        for (int d0 = 0; d0 < 4; ++d0) qr[d0] = qn[d0];
        __syncthreads();
        if (k + 1 < 8) UNIT_LOAD(k + 1);
        UNIT_DECODE(k)
        const int qi = q0_ + r32, tlo = (thi_ - NT) < 0 ? 0 : (thi_ - NT);
        State st; st.mref = 0.f; st.lsum = 0.f;
#pragma unroll
        for (int r = 0; r < 16; ++r) { st.o0[r] = 0.f; st.o1[r] = 0.f; }
        {
            int ta = (q0_ - NB) >> 6; ta = ta < tlo ? tlo : ta;
            int tb = ((q0_ + 31) >> 6) + 1; tb = tb > thi_ ? thi_ : tb;
            run_range<MODE, MODE == 0>(lds, ta, tb, thi_ - NT, kro, vro, qr, st, wsf, r32, hi, q0_, qi, false, true, false);
        }
        float sink2 = 0.f; if (MODE == 0) sink2 = sinks[hq_] * LOG2E;
        epilogue<MODE>(lds, st, wid, lane, OB + ((size_t)b_ * SEQ + r_) * DM + hq_ * 64, (long)dil * DM, q0_, sink2, LSE + ((size_t)b_ * SEQ + r_) * 16 + hq_, (long)dil * 16, pass);
        __syncthreads();
    }
#undef UNIT_LOAD
#undef UNIT_DECODE
}
}

constexpr size_t MiB = 1u << 20;
constexpr size_t WS_W = 8 * MiB, WS_XN = 112 * MiB, WS_O = 176 * MiB, WS_LSE = 240 * MiB, WS_KM = 242 * MiB, WS_ROPE = 243 * MiB, WS_QKV = 246 * MiB, WS_END = 502 * MiB;
constexpr size_t W_AQKV = 0, W_AO = 3145728, W_BQKV = 5242880, W_BO = 14680064, W_CQKV = 15728640, W_CO = 18874368, W_GU = 19922944, W_DN = 42991616, W_TOTAL = 54525952;
static_assert(WS_W + W_TOTAL * 2 <= WS_XN, "weights region");
constexpr int LDS_BYTES = 147456;
static_assert(att::ATT_LDS <= 143360 && pg8::STAGE_BYTES + 8192 + 2048 <= 143360, "phase LDS below the barrier's two set-up words");

struct Args { const void* in[15]; float* out; unsigned char* ws; int ph_lo, ph_hi; };

__device__ __forceinline__ float wave_sum(float v) {
#pragma unroll
    for (int o = 1; o < 64; o <<= 1) v += __shfl_xor(v, o);
    return v;
}
__device__ __forceinline__ int rope_perm32(int l) { return (l < 16) ? ((l >> 1) + 8 * (l & 1)) : l; }
__device__ __forceinline__ void transpose_item(const float* W, int K, int Nsrc, bf16_t* WT, int k0, int ns0, int nd0, LAS float* scr, int lane, bool rperm) {
    const int sl = rperm ? rope_perm32(lane & 31) : (lane & 31);
    float tv[32];
    const float* wp = W + (size_t)(k0 + (lane >> 5)) * Nsrc + ns0 + sl;
#pragma unroll
    for (int i = 0; i < 32; ++i) tv[i] = wp[(size_t)(2 * i) * Nsrc];
#pragma unroll
    for (int i = 0; i < 32; ++i) scr[(2 * i + (lane >> 5)) * 33 + (lane & 31)] = tv[i];
    asm volatile("s_waitcnt lgkmcnt(0)" ::: "memory");
    const int c = lane & 7;
#pragma unroll
    for (int j = 0; j < 4; ++j) { const int n = (lane >> 3) + 8 * j; const LAS float* s = scr + (8 * c) * 33 + n;
        u32x4 o; o.x = cvtpk(s[0 * 33], s[1 * 33]); o.y = cvtpk(s[2 * 33], s[3 * 33]); o.z = cvtpk(s[4 * 33], s[5 * 33]); o.w = cvtpk(s[6 * 33], s[7 * 33]);
        *(u32x4*)(WT + (size_t)(nd0 + n) * K + k0 + 8 * c) = o; }
    asm volatile("s_waitcnt lgkmcnt(0)" ::: "memory");
}
__device__ __forceinline__ bool transpose_family(int& r, const float* src, bf16_t* dst, int nmat, int K, int N, bool gu, LAS float* scr, int lane, int rope_mode = 0) {
    const int nblk = N / 32, per = (K / 64) * nblk, tot = nmat * per;
    if (r >= tot) { r -= tot; return false; }
    const int mat = r / per, it = r % per, kb = it / nblk, nb = it % nblk;
    const int nd0 = 32 * nb; int ns0 = nd0;
    if (gu) { const int tile = nd0 >> 8, within = nd0 & 255; ns0 = (within >> 7) * DFF + tile * 128 + (within & 127); }
    const bool rperm = ((nd0 & 63) == 0) && ((rope_mode == 1 && nd0 < 1280) || (rope_mode == 2 && (nd0 % 3072) < 2048));
    transpose_item(src + (size_t)mat * K * N, K, N, dst + (size_t)mat * K * N, 64 * kb, ns0, nd0, scr, lane, rperm);
    return true;
}
__device__ __forceinline__ void sincos_tab(float ang, float& c, float& s) {
    const double a = (double)ang; const double n = __builtin_rint(a * 0.63661977236758134308);
    double r = __builtin_fma(-n, 1.57079632679489655800, a); r = __builtin_fma(-n, 6.12323399573676603587e-17, r);
    const float x = (float)r, x2 = x * x;
    const float sp = x * (1.f + x2 * (-1.6666667163e-1f + x2 * (8.3333337680e-3f + x2 * (-1.9841270114e-4f + x2 * 2.7557314297e-6f))));
    const float cp = 1.f + x2 * (-0.5f + x2 * (4.1666667908e-2f + x2 * (-1.3888889225e-3f + x2 * (2.4801587642e-5f + x2 * (-2.7557314297e-7f)))));
    const int q = ((int)n) & 3;
    const float ss = (q & 1) ? cp : sp, cc = (q & 1) ? sp : cp;
    s = (q & 2) ? -ss : ss; c = ((q + 1) & 2) ? -cc : cc;
}

#define XB_TMO      128
#define XB_XCNT(j)  (256  + 64 * (j))
#define XB_XSUB(j)  (1280 + 64 * (j))
#define XB_XGEN(j)  (2304 + 64 * (j))
#define XB_TOP      3328
#define XB_TOPGEN   3392
#define XCD_BAR_WORDS 3456
#define XB_SPIN_CAP (1u << 22)
__device__ __forceinline__ unsigned xb_ld(unsigned* p)              { return __hip_atomic_load(p, __ATOMIC_RELAXED, __HIP_MEMORY_SCOPE_AGENT); }
__device__ __forceinline__ unsigned xb_add(unsigned* p, unsigned v) { return __hip_atomic_fetch_add(p, v, __ATOMIC_RELAXED, __HIP_MEMORY_SCOPE_AGENT); }
__device__ __forceinline__ unsigned xb_xcc_id() { return (unsigned)__builtin_amdgcn_s_getreg((3 << 11) | 20) & 0xFu; }
#define XB_SPIN(cond, bar) do { unsigned _sp = 0; while (cond) { __builtin_amdgcn_s_sleep(1); \
    if ((++_sp & 255u) == 0u) { if (xb_ld(&(bar)[XB_TMO])) break; if (_sp > XB_SPIN_CAP) { atomicAdd(&(bar)[XB_TMO], 1u); break; } } } } while (0)
struct XcdBarrier { unsigned* bar; unsigned x; volatile LAS unsigned* st; };
__device__ __forceinline__ XcdBarrier xcd_barrier_post(unsigned* bar, volatile LAS unsigned* st) {
    XcdBarrier b; b.bar = bar; b.x = xb_xcc_id(); b.st = st;
    if (threadIdx.x == 0) (void)xb_add(&bar[XB_XCNT(b.x)], 1u);
    return b;
}
__device__ __forceinline__ void xcd_barrier_complete(unsigned* bar, unsigned x, unsigned& nloc, unsigned& nx) {
    const unsigned G = gridDim.x * gridDim.y * gridDim.z;
    unsigned sum, cnt, mine, sp = 0u;
    for (;;) {
        sum = 0u; cnt = 0u; mine = 0u;
#pragma unroll
        for (unsigned j = 0; j < 16; ++j) { const unsigned c = xb_ld(&bar[XB_XCNT(j)]); sum += c; cnt += (c > 0u) ? 1u : 0u; mine = (j == x) ? c : mine; }
        if (sum == G) break;
        __builtin_amdgcn_s_sleep(1);
        if ((++sp & 255u) == 0u) { if (xb_ld(&bar[XB_TMO])) break; if (sp > XB_SPIN_CAP) { atomicAdd(&bar[XB_TMO], 1u); break; } }
    }
    nloc = mine > 0u ? mine : 1u; nx = cnt > 0u ? cnt : 1u;
}
__device__ __forceinline__ void xcd_barrier(const XcdBarrier& b) {
    asm volatile("s_waitcnt vmcnt(0)" ::: "memory");
    __syncthreads();
    if (threadIdx.x == 0) {
        unsigned* bar = b.bar;
        __builtin_amdgcn_s_waitcnt(0);
        unsigned nloc = b.st[0], nx = b.st[1];
        if (nloc == 0u) { xcd_barrier_complete(bar, b.x, nloc, nx); b.st[0] = nloc; b.st[1] = nx; }
        const unsigned old = xb_add(&bar[XB_XSUB(b.x)], 1u);
        const unsigned gen = old / nloc;
        if (old + 1u == (gen + 1u) * nloc) {
            __builtin_amdgcn_fence(__ATOMIC_RELEASE, "agent");
            asm volatile("s_waitcnt vmcnt(0)" ::: "memory");
            const unsigned og = xb_add(&bar[XB_TOP], 1u);
            const unsigned tg = og / nx;
            if (og + 1u == (tg + 1u) * nx) xb_add(&bar[XB_TOPGEN], 1u);
            else XB_SPIN(xb_ld(&bar[XB_TOPGEN]) == tg, bar);
            __builtin_amdgcn_fence(__ATOMIC_ACQUIRE, "agent");
            xb_add(&bar[XB_XGEN(b.x)], 1u);
            asm volatile("s_waitcnt vmcnt(0)" ::: "memory");
        } else {
            XB_SPIN(xb_ld(&bar[XB_XGEN(b.x)]) == gen, bar);
            __builtin_amdgcn_fence(__ATOMIC_ACQUIRE, "agent");
            asm volatile("s_waitcnt vmcnt(0)" ::: "memory");
        }
    }
    __syncthreads();
}
constexpr int MISC_OFF = 143360;

__global__ void __launch_bounds__(512, 2) mega(Args args) {
    extern __shared__ __attribute__((aligned(16))) unsigned char lds_raw[];
    LAS unsigned char* lds = (LAS unsigned char*)lds_raw;
    cg::grid_group grid = cg::this_grid();
    const int tid0 = threadIdx.x, wave = __builtin_amdgcn_readfirstlane(tid0 >> 6);
#define LTID() int tid = threadIdx.x; asm volatile("" : "+v"(tid)); const int lane = tid & 63; (void)lane
    const int G = gridDim.x, bx = blockIdx.x;
    const int vcu = (G % 8 == 0) ? (bx % 8) * (G / 8) + bx / 8 : bx;
    const int gw = vcu * 8 + wave, NGW = G * 8;
    unsigned char* ws = args.ws;
    const float* x_in = (const float*)args.in[0]; const int* positions = (const int*)args.in[1];
    const float* ln_g = (const float*)args.in[2]; const float* ln_b = (const float*)args.in[3];
    float* out = args.out;
    bf16_t* Wb = (bf16_t*)(ws + WS_W); bf16_t* XN = (bf16_t*)(ws + WS_XN); bf16_t* OB = (bf16_t*)(ws + WS_O);
    float* LSE = (float*)(ws + WS_LSE); float* KMEAN = (float*)(ws + WS_KM); float* ROPE = (float*)(ws + WS_ROPE);
    bf16_t* QKV = (bf16_t*)(ws + WS_QKV); bf16_t* HB = QKV;
    float* BIASP = (float*)(ws + 3 * MiB);
    bf16_t* XLO = (bf16_t*)(ws + 438 * MiB);
    unsigned* CNT = (unsigned*)(ws + 1 * MiB); unsigned long long* XBUF = (unsigned long long*)(ws + 2 * MiB);
    const int lo = args.ph_lo, hi = args.ph_hi;
    int ph = 0;
    unsigned* BARW = (unsigned*)ws;
    if (tid0 < 2) ((volatile LAS unsigned*)(lds + MISC_OFF))[tid0] = 0u;
    if (bx == 0) { for (int i = tid0; i < XCD_BAR_WORDS; i += 512) __hip_atomic_store(BARW + i, 0u, __ATOMIC_RELAXED, __HIP_MEMORY_SCOPE_AGENT); }
    __syncthreads();
    XcdBarrier xbar; xbar.bar = BARW; xbar.x = 0; xbar.st = (volatile LAS unsigned*)(lds + MISC_OFF);
#define RUN() (ph >= lo && ph < hi)
#define SEAM() do { if (ph + 1 < hi) { if (ph == 0) { grid.sync(); xbar = xcd_barrier_post(BARW, (volatile LAS unsigned*)(lds + MISC_OFF)); } else xcd_barrier(xbar); } } while (0)

    if (RUN()) {
        LTID();
        LAS float* scr = (LAS float*)(lds + wave * 16384);
        constexpr int NITEMS = (int)(W_TOTAL / 2048);
        for (int it = gw; it < NITEMS; it += NGW) {
            int r = it;
            if (transpose_family(r, (const float*)args.in[4], Wb + W_AQKV, 2, DM, 1536, false, scr, lane, 1)) continue;
            if (transpose_family(r, (const float*)args.in[7], Wb + W_AO, 2, DM, DM, false, scr, lane)) continue;
            if (transpose_family(r, (const float*)args.in[9], Wb + W_BQKV, 1, DM, 9216, false, scr, lane, 2)) continue;
            if (transpose_family(r, (const float*)args.in[10], Wb + W_BO, 1, DM, DM, false, scr, lane)) continue;
            if (transpose_family(r, (const float*)args.in[11], Wb + W_CQKV, 1, DM, 3072, false, scr, lane, 2)) continue;
            if (transpose_family(r, (const float*)args.in[12], Wb + W_CO, 1, DM, DM, false, scr, lane)) continue;
            if (transpose_family(r, (const float*)args.in[13], Wb + W_GU, 4, DM, 2 * DFF, true, scr, lane)) continue;
            transpose_family(r, (const float*)args.in[14], Wb + W_DN, 4, DFF, DM, false, scr, lane);
        }
        for (int m = gw; m < MTOK; m += NGW) {
            const f32x4* xr = (const f32x4*)(x_in + (size_t)m * DM) + lane; u32x2* o8 = (u32x2*)(XN + (size_t)m * DM) + lane;
#pragma unroll
            for (int j = 0; j < 4; ++j) { const f32x4 v = xr[64 * j]; u32x2 w; w.x = cvtpk(v[0], v[1]); w.y = cvtpk(v[2], v[3]); o8[64 * j] = w; }
        }
        for (int e = vcu * 512 + tid; e < 8 * 128 * 64; e += G * 512) CNT[e] = 0u;
        for (int e = vcu * 512 + tid; e < 2 * 1536; e += G * 512) {
            const int c = e % 1536, l = c & 63; const int oc = (c < 1280 && l < 16) ? (c - l + rope_perm32(l)) : c;
            BIASP[e] = ((const float*)args.in[5])[e - c + oc];
        }
        for (int e = vcu * 512 + tid; e < MTOK * 8; e += G * 512) {
            const int m = e >> 3, j = e & 7;
            const float inv = (j == 0) ? 1.0f : (j == 1) ? 0.1939227432012558f : (j == 2) ? 0.03760603070259094f : (j == 3) ? 0.007292664609849453f : (j == 4) ? 0.0014142135623842478f
                            : (j == 5) ? 0.00027424818836152554f : (j == 6) ? 5.3182957344688475e-05f : 1.0313385246263351e-05f;
            const float ang = (float)positions[m] * inv;
            float c, s; sincos_tab(ang, c, s);
            { bf16_t* rh = (bf16_t*)ROPE + (size_t)m * 16 + (j >> 2) * 8 + (j & 3); rh[0] = (bf16_t)(cvtpk(c, 0.f) & 0xffffu); rh[4] = (bf16_t)(cvtpk(s, 0.f) & 0xffffu); }
        }
        SEAM();
    }
    ++ph;

    for (int layer = 0; layer < DEPTH; ++layer) {
        const int kind = layer % 3, jj = layer / 3;
        const int npass = (kind == 1) ? 3 : 1;
        const int ncol = (kind == 0) ? 1536 : 3072;
        for (int pass = 0; pass < npass; ++pass) {
            if (RUN()) {
                const bf16_t* Wq = (kind == 0) ? Wb + W_AQKV + (size_t)jj * DM * 1536 : (kind == 1) ? Wb + W_BQKV + (size_t)pass * 3072 * DM : Wb + W_CQKV;
                pg8::Gemm g{XN, Wq, MTOK, ncol, DM}; pg8::StaticOrder S; S.init(MTOK, ncol, G, bx);
                pg8::EpiQKV E{QKV, ncol, (kind == 0) ? BIASP + (size_t)jj * 1536 : nullptr, (kind == 0) ? 1280 : 2048, 1024, ROPE};
                pg8::gemm_phase<pg8::EpiQKV, pg8::StaticOrder, true, true>(lds, g, S, E);
                SEAM();
            }
            ++ph;
            if (RUN()) {
                                for (int vc = vcu; vc < 256; vc += G) {
                    if (kind == 0) att::banded_phase<0>(lds, vc, QKV, OB, LSE, (const float*)args.in[6] + jj * 16, 0);
                    else if (kind == 1) att::banded_phase<1>(lds, vc, QKV, OB, LSE, nullptr, pass);
                    else {
                        att::moba_phase(lds, vc, QKV, OB);
                    }
                }
                SEAM();
            }
            ++ph;
        }
        for (int sub = 0; sub < 2; ++sub) {
            if (sub == 1) {
                if (RUN()) {
                    pg8::Gemm g{XN, Wb + W_GU + (size_t)layer * DM * 2 * DFF, MTOK, 2 * DFF, DM}; pg8::StaticOrder S; S.init(MTOK, 2 * DFF, G, bx);
                    pg8::EpiSwiGLU E{HB};
                    pg8::gemm_phase<pg8::EpiSwiGLU, pg8::StaticOrder, true, true>(lds, g, S, E);
                    SEAM();
                }
                ++ph;
            }
            if (RUN()) {
                const bf16_t* Wo = (kind == 0) ? Wb + W_AO + (size_t)jj * DM * DM : (kind == 1) ? Wb + W_BO : Wb + W_CO;
                const bf16_t* Wd = Wb + W_DN + (size_t)layer * DM * DFF;
                const float* bias = (sub == 0 && kind == 0) ? (const float*)args.in[8] + (size_t)jj * DM : nullptr;
                const float* xres = (layer == 0 && sub == 0) ? x_in : nullptr;
                float* outp = (layer == DEPTH - 1 && sub == 1) ? out : nullptr;
                const float* gp = ln_g + (size_t)(layer * 2 + sub) * DM; const float* bp = ln_b + (size_t)(layer * 2 + sub) * DM;
                pg8::Gemm g{sub == 0 ? OB : HB, sub == 0 ? Wo : Wd, MTOK, DM, sub == 0 ? DM : DFF};
                {
                    pg8::PanelStats st{XBUF, CNT + (size_t)(layer * 2 + sub) * 128 * 64};
                    pg8::EpiLN E{xres, outp, XN, XLO, bias, gp, bp, st, 1, (outp == nullptr) ? 1 : 0};
                    pg8::StaticOrder S; S.init(MTOK, DM, G, bx);
                    pg8::gemm_phase<pg8::EpiLN, pg8::StaticOrder, true, true>(lds, g, S, E);
                }
                SEAM();
            }
            ++ph;
        }
    }
#undef RUN
#undef SEAM
}

constexpr int NPHASE = 1 + 5 + 9 + 5 + 5;

extern "C" void kernel_launch(void* const* d_in, const int* in_sizes, int n_in, void* d_out, int out_size, void* d_ws, size_t ws_size, hipStream_t stream) {
    static int grid = 0;
    if (grid == 0) {
        if (n_in != 15 || out_size != MTOK * DM || ws_size < WS_END) { fprintf(stderr, "kernel_launch: unexpected shapes (n_in %d out %d ws %zu)\n", n_in, out_size, ws_size); grid = -1; return; }
        int dev = 0, cus = 0, per_cu = 0;
        (void)hipGetDevice(&dev); (void)hipDeviceGetAttribute(&cus, hipDeviceAttributeMultiprocessorCount, dev);
        if (hipFuncSetAttribute((const void*)mega, hipFuncAttributeMaxDynamicSharedMemorySize, LDS_BYTES) != hipSuccess) { fprintf(stderr, "kernel_launch: hipFuncSetAttribute failed\n"); grid = -1; return; }
        if (hipOccupancyMaxActiveBlocksPerMultiprocessor(&per_cu, (const void*)mega, 512, LDS_BYTES) != hipSuccess || per_cu < 1) { fprintf(stderr, "kernel_launch: occupancy query says %d\n", per_cu); per_cu = 1; }
        (void)hipGetLastError();
        grid = cus * per_cu;
        if (grid > 256) grid = 256;
    }
    if (grid < 0) return;
    Args a{};
    for (int i = 0; i < 15; ++i) a.in[i] = d_in[i];
    a.out = (float*)d_out; a.ws = (unsigned char*)d_ws;
#if MK_MULTI
    for (int p = 0; p < NPHASE; ++p) { a.ph_lo = p; a.ph_hi = p + 1; hipLaunchKernelGGL(mega, dim3(grid), dim3(512), LDS_BYTES, stream, a); }
#else
    a.ph_lo = 0; a.ph_hi = NPHASE;
    void* kargs[] = {&a};
    hipError_t e = hipLaunchCooperativeKernel((const void*)mega, dim3(grid), dim3(512), kargs, LDS_BYTES, stream);
    if (e != hipSuccess) fprintf(stderr, "cooperative launch failed: %s (grid %d)\n", hipGetErrorString(e), grid);
#endif
}
```
